# Optimizing an MI355X kernel written in HIP

```python
import jax, jax.numpy as jnp
from jax import lax
import numpy as np

D_MODEL = 1024
BATCH = 16
SEQ = 2048
DEPTH = 4

GRID_W = 64
CTX_LEN = 256
N_MIXERS = 2
CONV_WIDTH = 3
GLA_HEADS = 4
GLA_DK_TOT = D_MODEL // 2
GLA_DV_TOT = D_MODEL
GLA_DK = GLA_DK_TOT // GLA_HEADS
GLA_DV = GLA_DV_TOT // GLA_HEADS
GLA_GATE_RANK = 16
GLA_TAU = 16.0
GLA_CHUNK = 64
D_FF = -(-8 * D_MODEL // (3 * 256)) * 256
N_ADA = 6
EPS = 1e-6

kernel_name = "hybrid_conv_gla_diffusion_trunk"


def rmsnorm(x, g):
    xf = x.astype(jnp.float32)
    y = xf * lax.rsqrt(jnp.mean(xf * xf, axis=-1, keepdims=True) + EPS)
    return (y * g.astype(jnp.float32)).astype(x.dtype)


def ada_terms(cond, w, b):
    return jnp.split(jax.nn.silu(cond) @ w + b, N_ADA, axis=-1)


def modulate(h, shift, scale):
    return h * (1.0 + scale) + shift


def conv3_seq(u, w):
    up = jnp.pad(u, ((0, 0), (1, 1), (0, 0)))
    return w[0] * up[:, :-2] + w[1] * up[:, 1:-1] + w[2] * up[:, 2:]


def conv3_grid(u, w):
    B, L, C = u.shape
    rows = L // GRID_W
    return conv3_seq(u.reshape(B * rows, GRID_W, C), w).reshape(B, L, C)


def short_conv_mixer(h, w_in, conv_w, w_out, on_grid):
    gate_b, gate_c, hv = jnp.split(h @ w_in, 3, axis=-1)
    u = gate_c * hv
    conv = conv3_grid(u, conv_w) if on_grid else conv3_seq(u, conv_w)
    return (gate_b * conv) @ w_out


def gla_project(h, w_in, b_r, w_a1, w_a2, b_a):
    B, L, _ = h.shape
    q, k, v, r = jnp.split(h @ w_in, [GLA_DK_TOT, 2 * GLA_DK_TOT, 2 * GLA_DK_TOT + GLA_DV_TOT], axis=-1)

    def heads(t, d):
        return t.reshape(B, L, GLA_HEADS, d).transpose(0, 2, 1, 3).astype(jnp.float32)

    q = heads(q, GLA_DK) * (GLA_DK ** -0.5)
    k = heads(k, GLA_DK)
    v = heads(v, GLA_DV)
    logit = jnp.einsum('zblr,zrk->zblk', jnp.einsum('bld,zdr->zblr', h, w_a1), w_a2) + b_a[:, None, None, :]
    la = jax.nn.log_sigmoid(logit.astype(jnp.float32)) / GLA_TAU
    la = la.reshape(2, B, L, GLA_HEADS, GLA_DK).transpose(0, 1, 3, 2, 4)
    return q, k, v, r + b_r, la


def gla_chunked(q, k, v, la, s0, with_output):
    B, H, T, dk = q.shape
    dv = v.shape[-1]
    n = T // GLA_CHUNK
    q = q.reshape(B, H, n, GLA_CHUNK, dk)
    k = k.reshape(B, H, n, GLA_CHUNK, dk)
    v = v.reshape(B, H, n, GLA_CHUNK, dv)
    b = jnp.cumsum(la.reshape(B, H, n, GLA_CHUNK, dk), axis=3)
    b_last = b[:, :, :, -1]
    k_dec = k * jnp.exp(b_last[:, :, :, None] - b)
    u = jnp.einsum('bhnsd,bhnse->bhnde', k_dec, v)

    def step(state, inp):
        decay, u_n = inp
        return decay[..., None] * state + u_n, state

    s_final, s_prev = lax.scan(step, s0, (jnp.moveaxis(jnp.exp(b_last), 2, 0), jnp.moveaxis(u, 2, 0)))
    if not with_output:
        return None, s_final
    s_prev = jnp.moveaxis(s_prev, 0, 2)
    q_dec = q * jnp.exp(b)
    o_inter = jnp.einsum('bhncd,bhnde->bhnce', q_dec, s_prev)
    scores = jnp.einsum('bhncd,bhnsd->bhncs', q_dec, k * jnp.exp(-b))
    mask = jnp.tril(jnp.ones((GLA_CHUNK, GLA_CHUNK), dtype=bool))
    scores = jnp.where(mask, scores, 0.0)
    o_intra = jnp.einsum('bhncs,bhnse->bhnce', scores, v)
    return (o_inter + o_intra).reshape(B, H, T, dv), s_final


def gla_output(o, r, norm_g, w_out, dtype):
    B, H, T, dv = o.shape
    o = rmsnorm(o.transpose(0, 2, 1, 3), norm_g).reshape(B, T, H * dv).astype(dtype)
    return (o * jax.nn.silu(r)) @ w_out


def gla_mixer(hl, hc, w_in, b_r, w_a1, w_a2, b_a, norm_g, w_out, ctx_out):
    ql, kl, vl, rl, la_l = gla_project(hl, w_in, b_r, w_a1, w_a2, b_a)
    qc, kc, vc, rc, la_c = gla_project(hc, w_in, b_r, w_a1, w_a2, b_a)
    flip = lambda t: jnp.flip(t, axis=2)
    s0 = jnp.zeros((hl.shape[0], GLA_HEADS, GLA_DK, GLA_DV), jnp.float32)
    o_cf, s_cf = gla_chunked(qc, kc, vc, la_c[0], s0, ctx_out)
    o_cb, s_cb = gla_chunked(flip(qc), flip(kc), flip(vc), flip(la_c[1]), s0, ctx_out)
    o_lf, _ = gla_chunked(ql, kl, vl, la_l[0], s_cf, True)
    o_lb, _ = gla_chunked(flip(ql), flip(kl), flip(vl), flip(la_l[1]), s_cb, True)
    yl = gla_output(o_lf + flip(o_lb), rl, norm_g, w_out, hl.dtype)
    yc = gla_output(o_cf + flip(o_cb), rc, norm_g, w_out, hc.dtype) if ctx_out else None
    return yl, yc


def swiglu(h, w_in, w_out):
    gate, up = jnp.split(h @ w_in, 2, axis=-1)
    return (jax.nn.silu(gate) * up) @ w_out


def setup_inputs(seed: int = 0) -> dict:
    key = jax.random.key(seed)
    ks = jax.random.split(key, 24)
    n_conv = (DEPTH + N_MIXERS - 1) // N_MIXERS
    n_gla = DEPTH // N_MIXERS
    nrm = lambda k, shape, s: jax.random.normal(k, shape, jnp.float32) * s
    d = D_MODEL
    return {
        "x": nrm(ks[0], (BATCH, SEQ, d), 1.0),
        "c": nrm(ks[1], (BATCH, d), 1.0),
        "ctx": nrm(ks[2], (BATCH, CTX_LEN, d), 1.0),
        "c_ctx": nrm(ks[3], (d,), 1.0),
        "ada_w": nrm(ks[4], (DEPTH, d, N_ADA * d), 0.5 * d ** -0.5),
        "ada_b": nrm(ks[5], (DEPTH, N_ADA * d), 0.01),
        "norm1_g": 1.0 + nrm(ks[6], (DEPTH, d), 0.02),
        "norm2_g": 1.0 + nrm(ks[7], (DEPTH, d), 0.02),
        "conv_w_in": nrm(ks[8], (n_conv, d, 3 * d), d ** -0.5),
        "conv_w": nrm(ks[9], (n_conv, CONV_WIDTH, d), CONV_WIDTH ** -0.5),
        "conv_w_out": nrm(ks[10], (n_conv, d, d), d ** -0.5),
        "gla_w_in": nrm(ks[11], (n_gla, d, 2 * GLA_DK_TOT + 2 * GLA_DV_TOT), d ** -0.5),
        "gla_b_r": nrm(ks[12], (n_gla, GLA_DV_TOT), 0.01),
        "gla_w_a1": nrm(ks[13], (n_gla, 2, d, GLA_GATE_RANK), d ** -0.5),
        "gla_w_a2": nrm(ks[14], (n_gla, 2, GLA_GATE_RANK, GLA_DK_TOT), GLA_GATE_RANK ** -0.5),
        "gla_b_a": nrm(ks[15], (n_gla, 2, GLA_DK_TOT), 0.01),
        "gla_norm_g": 1.0 + nrm(ks[16], (n_gla, GLA_DV), 0.02),
        "gla_w_out": nrm(ks[17], (n_gla, GLA_DV_TOT, d), GLA_DV_TOT ** -0.5),
        "ffn_w_in": nrm(ks[18], (DEPTH, d, 2 * D_FF), d ** -0.5),
        "ffn_w_out": nrm(ks[19], (DEPTH, D_FF, d), D_FF ** -0.5),
        "final_g": 1.0 + nrm(ks[20], (d,), 0.02),
    }


def reference(x, c, ctx, c_ctx, ada_w, ada_b, norm1_g, norm2_g, conv_w_in, conv_w, conv_w_out,
              gla_w_in, gla_b_r, gla_w_a1, gla_w_a2, gla_b_a, gla_norm_g, gla_w_out,
              ffn_w_in, ffn_w_out, final_g):
    cond_lat = c[:, None, :]
    for i in range(DEPTH):
        last = i == DEPTH - 1
        kind = i % N_MIXERS
        j = i // N_MIXERS
        need_ctx_in = (not last) or kind == 1
        sh1, sc1, g1, sh2, sc2, g2 = ada_terms(cond_lat, ada_w[i], ada_b[i])
        hl = modulate(rmsnorm(x, norm1_g[i]), sh1, sc1)
        if need_ctx_in:
            csh1, csc1, cg1, csh2, csc2, cg2 = ada_terms(c_ctx, ada_w[i], ada_b[i])
            hc = modulate(rmsnorm(ctx, norm1_g[i]), csh1, csc1)
        if kind == 0:
            yl = short_conv_mixer(hl, conv_w_in[j], conv_w[j], conv_w_out[j], True)
            yc = short_conv_mixer(hc, conv_w_in[j], conv_w[j], conv_w_out[j], False) if not last else None
        else:
            yl, yc = gla_mixer(hl, hc, gla_w_in[j], gla_b_r[j], gla_w_a1[j], gla_w_a2[j], gla_b_a[j],
                               gla_norm_g[j], gla_w_out[j], not last)
        x = x + g1 * yl
        x = x + g2 * swiglu(modulate(rmsnorm(x, norm2_g[i]), sh2, sc2), ffn_w_in[i], ffn_w_out[i])
        if not last:
            ctx = ctx + cg1 * yc
            ctx = ctx + cg2 * swiglu(modulate(rmsnorm(ctx, norm2_g[i]), csh2, csc2), ffn_w_in[i], ffn_w_out[i])
    return rmsnorm(x, final_g)
```

```cpp
#include <hip/hip_runtime.h>
#include <hip/hip_cooperative_groups.h>
#include <cstdio>
#include <cstdint>
namespace cg = cooperative_groups;

#define LAS __attribute__((address_space(3)))
typedef unsigned short bf16_t;
typedef short bf16x8 __attribute__((ext_vector_type(8)));
typedef float f32x4 __attribute__((ext_vector_type(4)));
typedef float f32x2 __attribute__((ext_vector_type(2)));
typedef unsigned u32x4 __attribute__((ext_vector_type(4)));
typedef unsigned u32x2 __attribute__((ext_vector_type(2)));

constexpr int DM = 1024, TL = 32768, TC = 4096, TT = TL + TC, DFF = 2816, NCOND = 17, NADA = 6144;
constexpr int LDS_BYTES = 147456;
constexpr size_t MiB = 1u << 20;
constexpr size_t WS_WIN = 0, WS_WOUT = 8 * MiB, WS_WF1 = 10 * MiB, WS_WF2 = 21 * MiB, WS_MOD = 27 * MiB, WS_XCTX = 29 * MiB,
                 WS_HZ = 45 * MiB, WS_BIG = 117 * MiB, WS_R = 333 * MiB, WS_OB = 405 * MiB, WS_END = 477 * MiB;
constexpr size_t BIG_Q = 0, BIG_K = 36 * MiB, BIG_LA = 72 * MiB, BIG_VT = 144 * MiB;

struct Params { const float* in[21]; float* out; unsigned char* ws; };
enum { I_X = 0, I_C, I_CTX, I_CCTX, I_ADAW, I_ADAB, I_N1G, I_N2G, I_CWIN, I_CW, I_CWOUT, I_GWIN, I_GBR, I_GA1, I_GA2, I_GBA, I_GNG, I_GWOUT, I_FWIN, I_FWOUT, I_FG };

__device__ __forceinline__ unsigned cvt_pk_bf16(float lo, float hi) { unsigned r; asm volatile("v_cvt_pk_bf16_f32 %0, %1, %2" : "=v"(r) : "v"(lo), "v"(hi)); return r; }
__device__ __forceinline__ float bf2f(unsigned short b) { return __uint_as_float(((unsigned)b) << 16); }
__device__ __forceinline__ unsigned short f2bf(float f) { return (unsigned short)(cvt_pk_bf16(f, 0.f) & 0xffffu); }
__device__ __forceinline__ float silu_f(float v) { return v / (1.0f + __expf(-v)); }
__device__ __forceinline__ float wave_sum(float v) {
#pragma unroll
    for (int o = 1; o < 64; o <<= 1) v += __shfl_xor(v, o);
    return v;
}
__device__ __forceinline__ int opaque_tid() { int t = threadIdx.x; asm volatile("" : "+v"(t)); return t; }
#define LDS_WAIT() asm volatile("s_waitcnt lgkmcnt(0)" ::: "memory")

namespace pg8 {
constexpr int BM = 256, BK = 64, HALF = 128, HTB = HALF * BK * 2, STAGE_BYTES = 8 * HTB, NXCD = 8, WGM = 8;
__host__ __device__ __forceinline__ int lds_byte(int r, int c) { const int st = (r >> 4) * 2 + (c >> 5), rr = r & 15, cc = c & 31, ob = rr * 64 + cc * 2; return st * 1024 + (ob ^ (((ob >> 9) & 1) << 5)); }
__host__ __device__ __forceinline__ void stage_rc(int b, int& R, int& C) { const int st = b / 1024, sb = b % 1024, swz = sb ^ (((sb >> 9) & 1) << 5); R = (st >> 1) * 16 + swz / 64; C = (st & 1) * 32 + (swz % 64) / 2; }

struct Unit { int pm, pn; };
struct Gemm { const bf16_t* A; const bf16_t* Bt; int M, N, K; };

struct StaticOrder {
    int nM, nN, nwg, G, c;
    __host__ __device__ void init(int M, int N, int G_, int c_) { nM = M / BM; nN = N / BM; nwg = nM * nN; G = G_; c = c_; }
    __host__ __device__ bool next(int i, Unit& u) const {
        const long L = (long)i * G + c; if (L >= nwg) return false;
        int wgid = (int)L; { const int q = nwg / NXCD, r = nwg % NXCD, xcd = wgid % NXCD, off = wgid / NXCD; wgid = (xcd < r ? xcd * (q + 1) : r * (q + 1) + (xcd - r) * q) + off; }
        const int nig = WGM * nN, gid = wgid / nig, fm = gid * WGM, gsz = (nM - fm) < WGM ? (nM - fm) : WGM;
        u.pm = fm + ((wgid % nig) % gsz); u.pn = (wgid % nig) / gsz; return true;
    }
};

template <class Epi, bool ALIGN_EPI = true>
__device__ __forceinline__ void gemm_phase(LAS unsigned char* lds, const Gemm g, const StaticOrder& S, const Epi& E) {
    const int tid = opaque_tid(), wid = __builtin_amdgcn_readfirstlane(tid >> 6), lane = tid & 63, wr = wid >> 2, wc = wid & 3, fr = lane & 15, fq = lane >> 4;
    const int K = g.K, nt = K / BK;
    unsigned voffA[2], voffB[2];
#pragma unroll
    for (int i = 0; i < 2; ++i) { int R, C; stage_rc(tid * 16 + i * 8192, R, C); voffA[i] = (unsigned)(R * K + C) * 2u; voffB[i] = (unsigned)(R * K + C) * 2u; }
    const size_t kstep = (size_t)(BK * 2);
    const size_t hstep = (size_t)HALF * K * 2;
    const size_t tstep = 2 * hstep;
    const unsigned ldsw = (unsigned)wid * 1024u;
    const int aoff = lds_byte(wr * 64 + fr, fq * 8), boff = lds_byte(wc * 32 + fr, fq * 8);
#define PG8_SA(b, h) (((b) * 2 + (h)) * HTB)
#define PG8_SB(b, h) ((4 + (b) * 2 + (h)) * HTB)
#define PG8_STAGE(bufoff, gbase, voff) do { _Pragma("unroll") for (int _i = 0; _i < 2; ++_i) \
        __builtin_amdgcn_global_load_lds((const unsigned*)((const char*)(gbase) + (voff)[_i]), (LAS unsigned*)(lds + (bufoff) + ldsw + _i * 8192), 16, 0, 0); } while (0)
#define PG8_LDA(dst, b, h) do { _Pragma("unroll") for (int m = 0; m < 4; ++m) _Pragma("unroll") for (int k = 0; k < 2; ++k) dst[m][k] = *(const LAS bf16x8*)(lds + PG8_SA(b, h) + aoff + m * 2048 + k * 1024); } while (0)
#define PG8_LDB(dst, b, h) do { _Pragma("unroll") for (int n = 0; n < 2; ++n) _Pragma("unroll") for (int k = 0; k < 2; ++k) dst[n][k] = *(const LAS bf16x8*)(lds + PG8_SB(b, h) + boff + n * 2048 + k * 1024); } while (0)
#define PG8_MMA(ai, bj, At, Bt) do { __builtin_amdgcn_s_setprio(1); _Pragma("unroll") for (int m = 0; m < 4; ++m) _Pragma("unroll") for (int n = 0; n < 2; ++n) _Pragma("unroll") for (int k = 0; k < 2; ++k) \
        acc[ai][bj][m][n] = __builtin_amdgcn_mfma_f32_16x16x32_bf16(Bt[n][k], At[m][k], acc[ai][bj][m][n], 0, 0, 0); __builtin_amdgcn_s_setprio(0); } while (0)
#define PG8_WAIT_V(n) asm volatile("s_waitcnt vmcnt(" #n ")" ::: "memory")
#define PG8_WAIT_L(n) asm volatile("s_waitcnt lgkmcnt(" #n ")" ::: "memory")
#define PG8_BAR __builtin_amdgcn_s_barrier()
#define PG8_SCHED __builtin_amdgcn_sched_barrier(0)
    Unit cur, nxt; int ui = 0;
    if (!S.next(0, cur)) return;
    f32x4 acc[2][2][4][2];
#pragma unroll
    for (int a = 0; a < 2; ++a)
#pragma unroll
        for (int b = 0; b < 2; ++b)
#pragma unroll
            for (int m = 0; m < 4; ++m)
#pragma unroll
                for (int n = 0; n < 2; ++n) acc[a][b][m][n] = (f32x4){0.f, 0.f, 0.f, 0.f};
    bf16x8 At[4][2], B0[2][2], B1[2][2];
    const char* cA = (const char*)g.A + (size_t)cur.pm * tstep; const char* cB = (const char*)g.Bt + (size_t)cur.pn * tstep;
    PG8_STAGE(PG8_SB(0, 0), cB, voffB); PG8_STAGE(PG8_SB(0, 1), cB + hstep, voffB); PG8_STAGE(PG8_SA(0, 0), cA, voffA); PG8_STAGE(PG8_SA(0, 1), cA + hstep, voffA);
    if (wr == 1) PG8_BAR;
    PG8_WAIT_V(2); PG8_BAR;
    PG8_STAGE(PG8_SB(1, 0), cB + kstep, voffB); PG8_STAGE(PG8_SA(1, 0), cA + kstep, voffA); PG8_STAGE(PG8_SB(1, 1), cB + hstep + kstep, voffB);
    PG8_WAIT_V(6); PG8_BAR;
    for (;;) {
        const bool has_next = S.next(ui + 1, nxt);
        const char* nA = has_next ? (const char*)g.A + (size_t)nxt.pm * tstep : cA; const char* nB = has_next ? (const char*)g.Bt + (size_t)nxt.pn * tstep : cB;
        for (int t = 0; t < nt; t += 2) {
            const bool last = (t == nt - 2);
            const char* a1 = cA + (size_t)(t + 1) * kstep;
            const char* a2 = last ? nA : cA + (size_t)(t + 2) * kstep; const char* b2 = last ? nB : cB + (size_t)(t + 2) * kstep;
            const char* a3 = a2 + kstep; const char* b3 = b2 + kstep;
            PG8_LDB(B0, 0, 0); PG8_LDB(B1, 0, 1); PG8_SCHED; PG8_LDA(At, 0, 0); PG8_STAGE(PG8_SA(1, 1), a1 + hstep, voffA);
            PG8_WAIT_V(8); PG8_WAIT_L(0); PG8_BAR; PG8_MMA(0, 0, At, B0); PG8_MMA(0, 1, At, B1); PG8_BAR; PG8_SCHED;
            PG8_LDA(At, 0, 1); PG8_STAGE(PG8_SB(0, 0), b2, voffB); PG8_STAGE(PG8_SB(0, 1), b2 + hstep, voffB); PG8_STAGE(PG8_SA(0, 0), a2, voffA);
            PG8_WAIT_V(8); PG8_WAIT_L(0); PG8_BAR; PG8_MMA(1, 0, At, B0); PG8_MMA(1, 1, At, B1); PG8_BAR; PG8_SCHED;
            PG8_LDB(B0, 1, 0); PG8_LDB(B1, 1, 1); PG8_SCHED; PG8_LDA(At, 1, 0); PG8_STAGE(PG8_SA(0, 1), a2 + hstep, voffA);
            PG8_WAIT_V(8); PG8_WAIT_L(0); PG8_BAR; PG8_MMA(0, 0, At, B0); PG8_MMA(0, 1, At, B1); PG8_BAR; PG8_SCHED;
            PG8_LDA(At, 1, 1); PG8_STAGE(PG8_SB(1, 0), b3, voffB); PG8_STAGE(PG8_SB(1, 1), b3 + hstep, voffB); PG8_STAGE(PG8_SA(1, 0), a3, voffA);
            PG8_WAIT_V(8); PG8_WAIT_L(0); PG8_BAR; PG8_MMA(1, 0, At, B0); PG8_MMA(1, 1, At, B1); PG8_BAR; PG8_SCHED;
        }
        if constexpr (ALIGN_EPI) { if (wr == 0) PG8_BAR; }
        E(acc, cur, wr, wc, fr, fq);
        if (!has_next) break;
#pragma unroll
        for (int a = 0; a < 2; ++a)
#pragma unroll
            for (int b = 0; b < 2; ++b)
#pragma unroll
                for (int m = 0; m < 4; ++m)
#pragma unroll
                    for (int n = 0; n < 2; ++n) acc[a][b][m][n] = (f32x4){0.f, 0.f, 0.f, 0.f};
        cur = nxt; cA = nA; cB = nB; ++ui;
        if constexpr (ALIGN_EPI) { if (wr == 1) PG8_BAR; }
    }
    PG8_WAIT_V(0);
    if constexpr (!ALIGN_EPI) { if (wr == 0) PG8_BAR; }
    PG8_BAR;
#undef PG8_SA
#undef PG8_SB
#undef PG8_STAGE
#undef PG8_LDA
#undef PG8_LDB
#undef PG8_MMA
#undef PG8_WAIT_V
#undef PG8_WAIT_L
#undef PG8_BAR
#undef PG8_SCHED
}
}
using pg8::Unit;
typedef f32x4 AccT[2][2][4][2];

struct EpiPlain {
    bf16_t* O; size_t ldc;
    __device__ __forceinline__ void operator()(const AccT& acc, const Unit& u, int wr, int wc, int fr, int fq) const {
        const int row0 = u.pm * 256 + wr * 64 + fr, col0 = u.pn * 256 + wc * 32 + 4 * fq;
#pragma unroll
        for (int ai = 0; ai < 2; ++ai)
#pragma unroll
            for (int m = 0; m < 4; ++m) { bf16_t* rowp = O + (size_t)(row0 + ai * 128 + m * 16) * ldc + col0;
#pragma unroll
                for (int bj = 0; bj < 2; ++bj)
#pragma unroll
                    for (int n = 0; n < 2; ++n) { const f32x4 v = acc[ai][bj][m][n]; u32x2 w; w.x = cvt_pk_bf16(v[0], v[1]); w.y = cvt_pk_bf16(v[2], v[3]); *(u32x2*)(rowp + bj * 128 + n * 16) = w; } }
    }
};
struct EpiGla {
    bf16_t *Q, *Kb, *R; unsigned short* LA; const float *b_r, *b_a;
    __device__ __forceinline__ void operator()(const AccT& acc, const Unit& u, int wr, int wc, int fr, int fq) const {
        const int row0 = u.pm * 256 + wr * 64 + fr, cl = wc * 32 + 4 * fq;
        const int pn = u.pn;
        if (pn < 4) {
            bf16_t* dst = (pn < 2 ? Q : Kb); const float scale = pn < 2 ? 0.08838834764831845f : 1.0f; const int col0 = (pn & 1) * 256 + cl;
#pragma unroll
            for (int ai = 0; ai < 2; ++ai)
#pragma unroll
                for (int m = 0; m < 4; ++m) { bf16_t* rowp = dst + (size_t)(row0 + ai * 128 + m * 16) * 512 + col0;
#pragma unroll
                    for (int bj = 0; bj < 2; ++bj)
#pragma unroll
                        for (int n = 0; n < 2; ++n) { const f32x4 v = acc[ai][bj][m][n] * scale; u32x2 w; w.x = cvt_pk_bf16(v[0], v[1]); w.y = cvt_pk_bf16(v[2], v[3]); *(u32x2*)(rowp + bj * 128 + n * 16) = w; } }
        } else if (pn < 8) {
            const int col0 = (pn - 4) * 256 + cl;
            f32x4 bv[2][2];
#pragma unroll
            for (int bj = 0; bj < 2; ++bj)
#pragma unroll
                for (int n = 0; n < 2; ++n) bv[bj][n] = *(const f32x4*)(b_r + col0 + bj * 128 + n * 16);
#pragma unroll
            for (int ai = 0; ai < 2; ++ai)
#pragma unroll
                for (int m = 0; m < 4; ++m) { bf16_t* rowp = R + (size_t)(row0 + ai * 128 + m * 16) * 1024 + col0;
#pragma unroll
                    for (int bj = 0; bj < 2; ++bj)
#pragma unroll
                        for (int n = 0; n < 2; ++n) { const f32x4 v = acc[ai][bj][m][n] + bv[bj][n]; u32x2 w; w.x = cvt_pk_bf16(silu_f(v[0]), silu_f(v[1])); w.y = cvt_pk_bf16(silu_f(v[2]), silu_f(v[3])); *(u32x2*)(rowp + bj * 128 + n * 16) = w; } }
        } else {
            const int col0 = (pn - 8) * 256 + cl;
            f32x4 bv[2][2];
#pragma unroll
            for (int bj = 0; bj < 2; ++bj)
#pragma unroll
                for (int n = 0; n < 2; ++n) bv[bj][n] = *(const f32x4*)(b_a + col0 + bj * 128 + n * 16);
#pragma unroll
            for (int ai = 0; ai < 2; ++ai)
#pragma unroll
                for (int m = 0; m < 4; ++m) { unsigned short* rowp = LA + (size_t)(row0 + ai * 128 + m * 16) * 1024 + col0;
#pragma unroll
                    for (int bj = 0; bj < 2; ++bj)
#pragma unroll
                        for (int n = 0; n < 2; ++n) { const f32x4 v = acc[ai][bj][m][n] + bv[bj][n]; unsigned short hh[4];
#pragma unroll
                            for (int j = 0; j < 4; ++j) { const float x = v[j]; const float ls = fminf(x, 0.f) - log1pf(__expf(-fabsf(x))); hh[j] = __builtin_bit_cast(unsigned short, (_Float16)(ls * 0.0625f)); }
                            u32x2 w; w.x = (unsigned)hh[0] | ((unsigned)hh[1] << 16); w.y = (unsigned)hh[2] | ((unsigned)hh[3] << 16); *(u32x2*)(rowp + bj * 128 + n * 16) = w; } }
        }
    }
};
struct EpiRes {
    const float *base_lat, *base_ctx; float *out_lat, *out_ctx; const float* gate;
    __device__ __forceinline__ void operator()(const AccT& acc, const Unit& u, int wr, int wc, int fr, int fq) const {
        const int rt = u.pm * 256; const bool isctx = rt >= TL; const int b = isctx ? 16 : (rt >> 11);
        const int colt = u.pn * 256 + wc * 32 + 4 * fq;
        const float* gp = gate + (size_t)b * NADA + colt;
        f32x4 gv[2][2];
#pragma unroll
        for (int bj = 0; bj < 2; ++bj)
#pragma unroll
            for (int n = 0; n < 2; ++n) gv[bj][n] = *(const f32x4*)(gp + bj * 128 + n * 16);
        const float* base = isctx ? base_ctx + (size_t)(rt - TL) * DM : base_lat + (size_t)rt * DM;
        float* out = isctx ? out_ctx + (size_t)(rt - TL) * DM : out_lat + (size_t)rt * DM;
#pragma unroll
        for (int ai = 0; ai < 2; ++ai)
#pragma unroll
            for (int m = 0; m < 4; ++m) { const size_t off = (size_t)(wr * 64 + fr + ai * 128 + m * 16) * DM + colt;
#pragma unroll
                for (int bj = 0; bj < 2; ++bj)
#pragma unroll
                    for (int n = 0; n < 2; ++n) { const f32x4 bs = *(const f32x4*)(base + off + bj * 128 + n * 16); *(f32x4*)(out + off + bj * 128 + n * 16) = bs + gv[bj][n] * acc[ai][bj][m][n]; }
                asm volatile("" ::: "memory"); }
    }
};
struct EpiSwiglu {
    bf16_t* F;
    __device__ __forceinline__ void operator()(const AccT& acc, const Unit& u, int wr, int wc, int fr, int fq) const {
        const int row0 = u.pm * 256 + wr * 64 + fr, col0 = u.pn * 128 + wc * 32 + 4 * fq;
#pragma unroll
        for (int ai = 0; ai < 2; ++ai)
#pragma unroll
            for (int m = 0; m < 4; ++m) { bf16_t* rowp = F + (size_t)(row0 + ai * 128 + m * 16) * DFF + col0;
#pragma unroll
                for (int n = 0; n < 2; ++n) { const f32x4 gt = acc[ai][0][m][n], up = acc[ai][1][m][n]; u32x2 w;
                    w.x = cvt_pk_bf16(silu_f(gt[0]) * up[0], silu_f(gt[1]) * up[1]); w.y = cvt_pk_bf16(silu_f(gt[2]) * up[2], silu_f(gt[3]) * up[3]); *(u32x2*)(rowp + n * 16) = w; } }
    }
};

__device__ __forceinline__ void ada_phase(LAS unsigned char* lds, const Params& P) {
    LAS float* sc = (LAS float*)lds;
    LAS float* red = sc + NCOND * 1024;
    const int tid = opaque_tid(), wave = tid >> 6, lane = tid & 63;
    const float* c = P.in[I_C]; const float* cctx = P.in[I_CCTX]; const float* adaw = P.in[I_ADAW]; const float* adab = P.in[I_ADAB];
    float* mod = (float*)(P.ws + WS_MOD);
    if ((int)blockIdx.x >= 192) return;
    for (int idx = tid; idx < NCOND * 1024; idx += 512) { const int b = idx >> 10, k = idx & 1023; const float v = b < 16 ? c[b * 1024 + k] : cctx[k]; sc[idx] = silu_f(v); }
    __syncthreads();
    for (int item = blockIdx.x; item < 192; item += gridDim.x) {
        const int l = item / 48, n0 = (item % 48) * 128;
        float acc[NCOND][2];
#pragma unroll
        for (int b = 0; b < NCOND; ++b) { acc[b][0] = 0.f; acc[b][1] = 0.f; }
        const float* wbase = adaw + ((size_t)l * 1024) * NADA + n0 + 2 * lane;
        for (int k = 128 * wave; k < 128 * wave + 128; k += 4) {
            f32x2 wv[4];
#pragma unroll
            for (int i = 0; i < 4; ++i) wv[i] = *(const f32x2*)(wbase + (size_t)(k + i) * NADA);
#pragma unroll
            for (int b = 0; b < NCOND; ++b) { const f32x4 s4 = *(const LAS f32x4*)(sc + b * 1024 + k);
                acc[b][0] += s4[0] * wv[0][0] + s4[1] * wv[1][0] + s4[2] * wv[2][0] + s4[3] * wv[3][0];
                acc[b][1] += s4[0] * wv[0][1] + s4[1] * wv[1][1] + s4[2] * wv[2][1] + s4[3] * wv[3][1]; }
        }
#pragma unroll
        for (int b = 0; b < NCOND; ++b) { red[(wave * NCOND + b) * 128 + 2 * lane] = acc[b][0]; red[(wave * NCOND + b) * 128 + 2 * lane + 1] = acc[b][1]; }
        __syncthreads();
        for (int idx = tid; idx < NCOND * 128; idx += 512) { const int b = idx >> 7, cc = idx & 127; float s = 0.f;
#pragma unroll
            for (int w = 0; w < 8; ++w) s += red[(w * NCOND + b) * 128 + cc];
            mod[((size_t)l * NCOND + b) * NADA + n0 + cc] = s + adab[l * NADA + n0 + cc]; }
        __syncthreads();
    }
}

__device__ __forceinline__ void transpose_item(const float* W, int K, int N, bf16_t* WT, int wt_row0, int k0, int n0, LAS float* scr, int lane) {
#pragma unroll 8
    for (int i = 0; i < 32; ++i) { const int kk = 2 * i + (lane >> 5); scr[kk * 33 + (lane & 31)] = W[(size_t)(k0 + kk) * N + n0 + (lane & 31)]; }
    LDS_WAIT(); asm volatile("" ::: "memory");
    const int c = lane & 7;
#pragma unroll
    for (int j = 0; j < 4; ++j) { const int n = (lane >> 3) + 8 * j; const LAS float* s = scr + (8 * c) * 33 + n;
        u32x4 o; o.x = cvt_pk_bf16(s[0 * 33], s[1 * 33]); o.y = cvt_pk_bf16(s[2 * 33], s[3 * 33]); o.z = cvt_pk_bf16(s[4 * 33], s[5 * 33]); o.w = cvt_pk_bf16(s[6 * 33], s[7 * 33]);
        *(u32x4*)(WT + (size_t)(wt_row0 + n) * K + k0 + 8 * c) = o; }
    LDS_WAIT(); asm volatile("" ::: "memory");
}
__device__ __forceinline__ void prep_layer(LAS unsigned char* lds, const Params& P, int layer) {
    const int tid = opaque_tid(), wave = tid >> 6, lane = tid & 63;
    const int kind = layer & 1, j = layer >> 1;
    LAS float* scr = (LAS float*)(lds + wave * 8704);
    bf16_t* Win_t = (bf16_t*)(P.ws + WS_WIN); bf16_t* Wout_t = (bf16_t*)(P.ws + WS_WOUT); bf16_t* Wf1_t = (bf16_t*)(P.ws + WS_WF1); bf16_t* Wf2_t = (bf16_t*)(P.ws + WS_WF2);
    const float* Win = (kind == 0 ? P.in[I_CWIN] : P.in[I_GWIN]) + (size_t)j * 1024 * 3072;
    const float* Wout = (kind == 0 ? P.in[I_CWOUT] : P.in[I_GWOUT]) + (size_t)j * 1024 * 1024;
    const float* Wf1 = P.in[I_FWIN] + (size_t)layer * 1024 * 5632;
    const float* Wf2 = P.in[I_FWOUT] + (size_t)layer * 2816 * 1024;
    const int gw = blockIdx.x * 8 + wave, NGW = gridDim.x * 8;
    for (int it = gw; it < 6272; it += NGW) {
        if (it < 1536) { const int kb = it / 96, n0 = (it % 96) * 32; const int row0 = kind == 0 ? n0 : (n0 < 1024 ? n0 : (n0 < 2048 ? n0 + 2048 : n0 - 1024));
            transpose_item(Win, 1024, 3072, Win_t, row0, kb * 64, n0, scr, lane); }
        else if (it < 2048) { const int r = it - 1536; const int kb = r / 32, n0 = (r % 32) * 32; transpose_item(Wout, 1024, 1024, Wout_t, n0, kb * 64, n0, scr, lane); }
        else if (it < 4864) { const int r = it - 2048; const int kb = r / 176, n0 = (r % 176) * 32;
            const int row0 = n0 < 2816 ? 256 * (n0 / 128) + (n0 % 128) : 256 * ((n0 - 2816) / 128) + 128 + ((n0 - 2816) % 128);
            transpose_item(Wf1, 1024, 5632, Wf1_t, row0, kb * 64, n0, scr, lane); }
        else { const int r = it - 4864; const int kb = r / 32, n0 = (r % 32) * 32; transpose_item(Wf2, 2816, 1024, Wf2_t, n0, kb * 64, n0, scr, lane); }
    }
    if (kind == 1) {
        const float* a1 = P.in[I_GA1] + (size_t)j * 2 * 1024 * 16; const float* a2 = P.in[I_GA2] + (size_t)j * 2 * 16 * 512;
        const int gt = blockIdx.x * 512 + tid, NT = gridDim.x * 512;
        for (int idx = gt; idx < 1024 * 128; idx += NT) {
            const int row = idx >> 7, kg = idx & 127, dir = row >> 9, d = row & 511;
            float a2v[16];
#pragma unroll
            for (int r = 0; r < 16; ++r) a2v[r] = a2[((size_t)dir * 16 + r) * 512 + d];
            float o[8];
#pragma unroll
            for (int kk = 0; kk < 8; ++kk) { const f32x4* ar = (const f32x4*)(a1 + ((size_t)dir * 1024 + 8 * kg + kk) * 16); float s = 0.f;
#pragma unroll
                for (int q = 0; q < 4; ++q) { const f32x4 av = ar[q]; s += av[0] * a2v[4 * q] + av[1] * a2v[4 * q + 1] + av[2] * a2v[4 * q + 2] + av[3] * a2v[4 * q + 3]; }
                o[kk] = s; }
            u32x4 w; w.x = cvt_pk_bf16(o[0], o[1]); w.y = cvt_pk_bf16(o[2], o[3]); w.z = cvt_pk_bf16(o[4], o[5]); w.w = cvt_pk_bf16(o[6], o[7]);
            *(u32x4*)(Win_t + (size_t)(2048 + row) * 1024 + 8 * kg) = w;
        }
    }
}

__device__ __forceinline__ void norm_mod_phase(const float* src_lat, const float* src_ctx, const float* gain, const float* modl, int shoff, int scoff, bf16_t* H, int nrows) {
    const int tid = opaque_tid(), wave = tid >> 6, lane = tid & 63;
    const int gw = blockIdx.x * 8 + wave, NGW = gridDim.x * 8;
    for (int r = gw; r < nrows; r += NGW) {
        const float* xrow = r < TL ? src_lat + (size_t)r * DM : src_ctx + (size_t)(r - TL) * DM; const int b = r < TL ? (r >> 11) : 16;
        const f32x4* xr = (const f32x4*)xrow + lane;
        f32x4 v[4]; float s = 0.f;
#pragma unroll
        for (int q = 0; q < 4; ++q) { v[q] = xr[64 * q]; s += (v[q][0] * v[q][0] + v[q][1] * v[q][1]) + (v[q][2] * v[q][2] + v[q][3] * v[q][3]); }
        const float rstd = rsqrtf(wave_sum(s) * (1.0f / DM) + 1e-6f);
        const float* mb = modl + (size_t)b * NADA;
#pragma unroll
        for (int q = 0; q < 4; ++q) { const int col = 4 * lane + 256 * q;
            const f32x4 g4 = *(const f32x4*)(gain + col), sc4 = *(const f32x4*)(mb + scoff + col), sh4 = *(const f32x4*)(mb + shoff + col);
            const f32x4 h = (v[q] * rstd * g4) * (sc4 + 1.0f) + sh4;
            u32x2 w; w.x = cvt_pk_bf16(h[0], h[1]); w.y = cvt_pk_bf16(h[2], h[3]); *(u32x2*)(H + (size_t)r * DM + col) = w; }
    }
}
__device__ __forceinline__ void final_norm_phase(const float* X, const float* gain, float* out) {
    const int tid = opaque_tid(), wave = tid >> 6, lane = tid & 63;
    const int gw = blockIdx.x * 8 + wave, NGW = gridDim.x * 8;
    for (int r = gw; r < TL; r += NGW) {
        const f32x4* xr = (const f32x4*)(X + (size_t)r * DM) + lane;
        f32x4 v[4]; float s = 0.f;
#pragma unroll
        for (int q = 0; q < 4; ++q) { v[q] = xr[64 * q]; s += (v[q][0] * v[q][0] + v[q][1] * v[q][1]) + (v[q][2] * v[q][2] + v[q][3] * v[q][3]); }
        const float rstd = rsqrtf(wave_sum(s) * (1.0f / DM) + 1e-6f);
#pragma unroll
        for (int q = 0; q < 4; ++q) { const int col = 4 * lane + 256 * q; const f32x4 g4 = *(const f32x4*)(gain + col); *(f32x4*)(out + (size_t)r * DM + col) = v[q] * rstd * g4; }
    }
}
__device__ __forceinline__ void conv_phase(const bf16_t* Pm, const float* cw, bf16_t* Z, int ntok) {
    const int gt = blockIdx.x * 512 + opaque_tid(), NT = gridDim.x * 512;
    const int total = ntok * 128;
    for (int idx = gt; idx < total; idx += NT) {
        const int t = idx >> 7, cg8 = (idx & 127) * 8;
        int pos, len; if (t < TL) { pos = t & 63; len = 64; } else { pos = (t - TL) & 255; len = 256; }
        const bf16_t* row = Pm + (size_t)t * 3072 + cg8;
        const u32x4 gbv = *(const u32x4*)(row);
        const u32x4 gc1 = *(const u32x4*)(row + 1024), hv1 = *(const u32x4*)(row + 2048);
        u32x4 gc0 = (u32x4){0, 0, 0, 0}, hv0 = gc0, gc2 = gc0, hv2 = gc0;
        if (pos > 0) { gc0 = *(const u32x4*)(row - 3072 + 1024); hv0 = *(const u32x4*)(row - 3072 + 2048); }
        if (pos < len - 1) { gc2 = *(const u32x4*)(row + 3072 + 1024); hv2 = *(const u32x4*)(row + 3072 + 2048); }
        float o[8];
#pragma unroll
        for (int q = 0; q < 4; ++q) {
#pragma unroll
            for (int hlf = 0; hlf < 2; ++hlf) { const int e = 2 * q + hlf; const int sh = hlf * 16;
                const float gb = bf2f((unsigned short)(gbv[q] >> sh));
                const float u0 = bf2f((unsigned short)(gc0[q] >> sh)) * bf2f((unsigned short)(hv0[q] >> sh));
                const float u1 = bf2f((unsigned short)(gc1[q] >> sh)) * bf2f((unsigned short)(hv1[q] >> sh));
                const float u2 = bf2f((unsigned short)(gc2[q] >> sh)) * bf2f((unsigned short)(hv2[q] >> sh));
                const int cch = cg8 + e;
                o[e] = gb * (cw[cch] * u0 + cw[1024 + cch] * u1 + cw[2048 + cch] * u2); } }
        u32x4 w; w.x = cvt_pk_bf16(o[0], o[1]); w.y = cvt_pk_bf16(o[2], o[3]); w.z = cvt_pk_bf16(o[4], o[5]); w.w = cvt_pk_bf16(o[6], o[7]);
        *(u32x4*)(Z + (size_t)t * DM + cg8) = w;
    }
}
__device__ __forceinline__ void gla_out_phase(const bf16_t* Of, const bf16_t* Ob, const bf16_t* R, const float* ng, bf16_t* G, int ntok) {
    const int tid = opaque_tid(), wave = tid >> 6, lane = tid & 63;
    const int gw = blockIdx.x * 8 + wave, NGW = gridDim.x * 8;
    for (int t = gw; t < ntok; t += NGW) {
        const size_t off = (size_t)t * DM + 16 * lane;
        const u32x4 a0 = *(const u32x4*)(Of + off), a1 = *(const u32x4*)(Of + off + 8), b0 = *(const u32x4*)(Ob + off), b1 = *(const u32x4*)(Ob + off + 8);
        const u32x4 r0 = *(const u32x4*)(R + off), r1 = *(const u32x4*)(R + off + 8);
        float o[16]; float s = 0.f;
#pragma unroll
        for (int q = 0; q < 4; ++q) {
            o[2 * q] = bf2f((unsigned short)(a0[q] & 0xffff)) + bf2f((unsigned short)(b0[q] & 0xffff)); o[2 * q + 1] = bf2f((unsigned short)(a0[q] >> 16)) + bf2f((unsigned short)(b0[q] >> 16));
            o[8 + 2 * q] = bf2f((unsigned short)(a1[q] & 0xffff)) + bf2f((unsigned short)(b1[q] & 0xffff)); o[8 + 2 * q + 1] = bf2f((unsigned short)(a1[q] >> 16)) + bf2f((unsigned short)(b1[q] >> 16)); }
#pragma unroll
        for (int e = 0; e < 16; ++e) s += o[e] * o[e];
        s += __shfl_xor(s, 1); s += __shfl_xor(s, 2); s += __shfl_xor(s, 4); s += __shfl_xor(s, 8);
        const float rstd = rsqrtf(s * (1.0f / 256.0f) + 1e-6f);
        const float* ngp = ng + ((16 * lane) & 255);
        float y[16];
#pragma unroll
        for (int q = 0; q < 4; ++q) {
            y[2 * q] = o[2 * q] * rstd * ngp[2 * q] * bf2f((unsigned short)(r0[q] & 0xffff)); y[2 * q + 1] = o[2 * q + 1] * rstd * ngp[2 * q + 1] * bf2f((unsigned short)(r0[q] >> 16));
            y[8 + 2 * q] = o[8 + 2 * q] * rstd * ngp[8 + 2 * q] * bf2f((unsigned short)(r1[q] & 0xffff)); y[8 + 2 * q + 1] = o[8 + 2 * q + 1] * rstd * ngp[8 + 2 * q + 1] * bf2f((unsigned short)(r1[q] >> 16)); }
        u32x4 w0, w1;
        w0.x = cvt_pk_bf16(y[0], y[1]); w0.y = cvt_pk_bf16(y[2], y[3]); w0.z = cvt_pk_bf16(y[4], y[5]); w0.w = cvt_pk_bf16(y[6], y[7]);
        w1.x = cvt_pk_bf16(y[8], y[9]); w1.y = cvt_pk_bf16(y[10], y[11]); w1.z = cvt_pk_bf16(y[12], y[13]); w1.w = cvt_pk_bf16(y[14], y[15]);
        *(u32x4*)(G + off) = w0; *(u32x4*)(G + off + 8) = w1;
    }
}

constexpr int SC_QD = 0, SC_KI = 17408, SC_KDT = 34816, SC_VT = 53248, SC_ST = 71680, SC_P = 106496, SC_TOT = 115712, SC_DEC = 117760;
constexpr int PQ = 136, PS = 72;
__device__ __forceinline__ void gla_scan_phase(LAS unsigned char* lds, const bf16_t* Q, const bf16_t* Kb, const unsigned short* LA, const bf16_t* VT, bf16_t* Of, bf16_t* Ob) {
    const int tid = opaque_tid(), w = __builtin_amdgcn_readfirstlane(tid >> 6), lane = tid & 63, fr = lane & 15, fq = lane >> 4;
    LAS bf16_t* QD = (LAS bf16_t*)(lds + SC_QD); LAS bf16_t* KI = (LAS bf16_t*)(lds + SC_KI); LAS bf16_t* KDT = (LAS bf16_t*)(lds + SC_KDT);
    LAS bf16_t* VTs = (LAS bf16_t*)(lds + SC_VT); LAS bf16_t* ST = (LAS bf16_t*)(lds + SC_ST); LAS bf16_t* Pm = (LAS bf16_t*)(lds + SC_P);
    LAS float* TOT = (LAS float*)(lds + SC_TOT); LAS float* DEC = (LAS float*)(lds + SC_DEC);
    const int d = tid & 127, seg = tid >> 7;
    for (int item = blockIdx.x; item < 256; item += gridDim.x) {
        const int es = item & 1, dir = (item >> 1) & 1, h = (item >> 2) & 3, b = item >> 4;
        bf16_t* Od = dir ? Ob : Of;
        for (int i = tid; i < 128 * PQ / 2; i += 512) ((LAS unsigned*)ST)[i] = 0u;
        f32x4 S[8];
#pragma unroll
        for (int dt = 0; dt < 8; ++dt) S[dt] = (f32x4){0.f, 0.f, 0.f, 0.f};
        __syncthreads();
        for (int step = 0; step < 36; ++step) {
            int tok0;
            if (step < 4) { const int cc = dir ? 3 - step : step; tok0 = TL + b * 256 + cc * 64; }
            else { const int lc = step - 4; const int cc = dir ? 31 - lc : lc; tok0 = b * 2048 + cc * 64; }
            const int colq = h * 128 + d;
            const unsigned short* lap = LA + (size_t)(tok0 + 16 * seg) * 1024 + dir * 512 + colq;
            float bl[16];
#pragma unroll
            for (int i = 0; i < 16; ++i) bl[i] = (float)__builtin_bit_cast(_Float16, lap[(size_t)i * 1024]);
            const bf16_t* qp = Q + (size_t)(tok0 + 16 * seg) * 512 + colq; const bf16_t* kp = Kb + (size_t)(tok0 + 16 * seg) * 512 + colq;
            unsigned short qraw[16], kraw[16];
#pragma unroll
            for (int i = 0; i < 16; ++i) { qraw[i] = qp[(size_t)i * 512]; kraw[i] = kp[(size_t)i * 512]; }
            u32x4 vtv[2];
#pragma unroll
            for (int i = 0; i < 2; ++i) { const int piece = tid + 512 * i; const int er = piece >> 3, pc = piece & 7; vtv[i] = *(const u32x4*)(VT + (size_t)(h * 256 + es * 128 + er) * TT + tok0 + 8 * pc); }
            float run = 0.f;
            if (dir == 0) {
#pragma unroll
                for (int i = 0; i < 16; ++i) { run += bl[i]; bl[i] = run; }
            } else {
#pragma unroll
                for (int i = 15; i >= 0; --i) { run += bl[i]; bl[i] = run; }
            }
            TOT[seg * 128 + d] = run;
            __syncthreads();
            const float t0 = TOT[d], t1 = TOT[128 + d], t2 = TOT[256 + d], t3 = TOT[384 + d];
            const float total = (t0 + t1) + (t2 + t3);
            float offs;
            if (dir == 0) offs = (seg > 0 ? t0 : 0.f) + (seg > 1 ? t1 : 0.f) + (seg > 2 ? t2 : 0.f);
            else offs = (seg < 3 ? t3 : 0.f) + (seg < 2 ? t2 : 0.f) + (seg < 1 ? t1 : 0.f);
            unsigned kdp[8];
#pragma unroll
            for (int i = 0; i < 16; i += 2) {
                const float b0 = bl[i] + offs, b1 = bl[i + 1] + offs;
                const float q0 = bf2f(qraw[i]), q1 = bf2f(qraw[i + 1]), k0 = bf2f(kraw[i]), k1 = bf2f(kraw[i + 1]);
                const unsigned qd = cvt_pk_bf16(q0 * __expf(b0), q1 * __expf(b1));
                const unsigned ki = cvt_pk_bf16(k0 * __expf(-b0), k1 * __expf(-b1));
                kdp[i >> 1] = cvt_pk_bf16(k0 * __expf(total - b0), k1 * __expf(total - b1));
                QD[(16 * seg + i) * PQ + d] = (bf16_t)(qd & 0xffff); QD[(16 * seg + i + 1) * PQ + d] = (bf16_t)(qd >> 16);
                KI[(16 * seg + i) * PQ + d] = (bf16_t)(ki & 0xffff); KI[(16 * seg + i + 1) * PQ + d] = (bf16_t)(ki >> 16);
            }
            *(LAS u32x4*)(KDT + d * PS + 16 * seg) = (u32x4){kdp[0], kdp[1], kdp[2], kdp[3]};
            *(LAS u32x4*)(KDT + d * PS + 16 * seg + 8) = (u32x4){kdp[4], kdp[5], kdp[6], kdp[7]};
            if (seg == 0) DEC[d] = __expf(total);
#pragma unroll
            for (int i = 0; i < 2; ++i) { const int piece = tid + 512 * i; const int er = piece >> 3, pc = piece & 7; *(LAS u32x4*)(VTs + er * PS + 8 * pc) = vtv[i]; }
            __syncthreads();
#pragma unroll
            for (int ti = 0; ti < 2; ++ti) {
                const int id = 2 * w + ti, ct = id >> 2, st = id & 3;
                f32x4 a4 = (f32x4){0.f, 0.f, 0.f, 0.f};
#pragma unroll
                for (int ks = 0; ks < 4; ++ks) {
                    const bf16x8 af = *(const LAS bf16x8*)(QD + (ct * 16 + fr) * PQ + ks * 32 + fq * 8);
                    const bf16x8 bf = *(const LAS bf16x8*)(KI + (st * 16 + fr) * PQ + ks * 32 + fq * 8);
                    a4 = __builtin_amdgcn_mfma_f32_16x16x32_bf16(af, bf, a4, 0, 0, 0);
                }
                const int s_ = st * 16 + fr;
#pragma unroll
                for (int rg = 0; rg < 4; ++rg) { const int c_ = ct * 16 + 4 * fq + rg; const bool keep = dir == 0 ? (s_ <= c_) : (s_ >= c_);
                    Pm[c_ * PS + s_] = keep ? f2bf(a4[rg]) : (bf16_t)0; }
            }
            f32x4 oacc[4];
#pragma unroll
            for (int ct = 0; ct < 4; ++ct) oacc[ct] = (f32x4){0.f, 0.f, 0.f, 0.f};
#pragma unroll
            for (int ks = 0; ks < 4; ++ks) {
                const bf16x8 af = *(const LAS bf16x8*)(ST + (16 * w + fr) * PQ + ks * 32 + fq * 8);
#pragma unroll
                for (int ct = 0; ct < 4; ++ct) { const bf16x8 bf = *(const LAS bf16x8*)(QD + (16 * ct + fr) * PQ + ks * 32 + fq * 8); oacc[ct] = __builtin_amdgcn_mfma_f32_16x16x32_bf16(af, bf, oacc[ct], 0, 0, 0); }
            }
            __syncthreads();
#pragma unroll
            for (int ks = 0; ks < 2; ++ks) {
                const bf16x8 af = *(const LAS bf16x8*)(VTs + (16 * w + fr) * PS + ks * 32 + fq * 8);
#pragma unroll
                for (int ct = 0; ct < 4; ++ct) { const bf16x8 bf = *(const LAS bf16x8*)(Pm + (16 * ct + fr) * PS + ks * 32 + fq * 8); oacc[ct] = __builtin_amdgcn_mfma_f32_16x16x32_bf16(af, bf, oacc[ct], 0, 0, 0); }
            }
#pragma unroll
            for (int ct = 0; ct < 4; ++ct) { u32x2 wv; wv.x = cvt_pk_bf16(oacc[ct][0], oacc[ct][1]); wv.y = cvt_pk_bf16(oacc[ct][2], oacc[ct][3]);
                *(u32x2*)(Od + (size_t)(tok0 + 16 * ct + fr) * DM + h * 256 + es * 128 + 16 * w + 4 * fq) = wv; }
#pragma unroll
            for (int dt = 0; dt < 8; ++dt) { const f32x4 dc = *(const LAS f32x4*)(DEC + 16 * dt + 4 * fq); S[dt] = S[dt] * dc; }
#pragma unroll
            for (int ks = 0; ks < 2; ++ks) {
                const bf16x8 bf = *(const LAS bf16x8*)(VTs + (16 * w + fr) * PS + ks * 32 + fq * 8);
#pragma unroll
                for (int dt = 0; dt < 8; ++dt) { const bf16x8 af = *(const LAS bf16x8*)(KDT + (16 * dt + fr) * PS + ks * 32 + fq * 8); S[dt] = __builtin_amdgcn_mfma_f32_16x16x32_bf16(af, bf, S[dt], 0, 0, 0); }
            }
#pragma unroll
            for (int dt = 0; dt < 8; ++dt) { u32x2 wv; wv.x = cvt_pk_bf16(S[dt][0], S[dt][1]); wv.y = cvt_pk_bf16(S[dt][2], S[dt][3]); *(LAS u32x2*)(ST + (16 * w + fr) * PQ + 16 * dt + 4 * fq) = wv; }
            __syncthreads();
        }
    }
}

__global__ void __launch_bounds__(512, 2) fwd_megakernel(Params P) {
    extern __shared__ __attribute__((aligned(16))) unsigned char lds_raw[];
    LAS unsigned char* lds = (LAS unsigned char*)lds_raw;
    cg::grid_group grid = cg::this_grid();
#define GSYNC() do { asm volatile("s_waitcnt vmcnt(0) lgkmcnt(0)" ::: "memory"); __syncthreads(); grid.sync(); } while (0)
    const int G = gridDim.x, bx = blockIdx.x;
    unsigned char* ws = P.ws;
    float* mod = (float*)(ws + WS_MOD);
    float* Xl = P.out; float* Xc = (float*)(ws + WS_XCTX);
    bf16_t* HZ = (bf16_t*)(ws + WS_HZ); bf16_t* BIG = (bf16_t*)(ws + WS_BIG);
    bf16_t* Win_t = (bf16_t*)(ws + WS_WIN); bf16_t* Wout_t = (bf16_t*)(ws + WS_WOUT); bf16_t* Wf1_t = (bf16_t*)(ws + WS_WF1); bf16_t* Wf2_t = (bf16_t*)(ws + WS_WF2);
    bf16_t* Qb = (bf16_t*)(ws + WS_BIG + BIG_Q); bf16_t* Kb = (bf16_t*)(ws + WS_BIG + BIG_K); unsigned short* LAb = (unsigned short*)(ws + WS_BIG + BIG_LA); bf16_t* VTb = (bf16_t*)(ws + WS_BIG + BIG_VT);
    bf16_t* Rb = (bf16_t*)(ws + WS_R); bf16_t* Obb = (bf16_t*)(ws + WS_OB);

#ifndef NO_ADA
    ada_phase(lds, P);
#endif
    GSYNC();
#pragma unroll 1
    for (int layer = 0; layer < 4; ++layer) {
        const int kind = layer & 1, j = layer >> 1; const bool last = layer == 3;
        const float* modl = mod + (size_t)layer * NCOND * NADA;
        const float* src_lat = layer == 0 ? P.in[I_X] : Xl; const float* src_ctx = layer == 0 ? P.in[I_CTX] : Xc;
        const int Mall = TT, Mres = last ? TL : TT;
#ifndef NO_PREP
        prep_layer(lds, P, layer);
#endif
        norm_mod_phase(src_lat, src_ctx, P.in[I_N1G] + layer * DM, modl, 0, 1024, HZ, Mall);
        GSYNC();
        if (kind == 1) {
            pg8::Gemm g{HZ, Win_t, Mall, 3072, 1024}; pg8::StaticOrder S; S.init(Mall, 3072, G, bx);
            EpiGla E{Qb, Kb, Rb, LAb, P.in[I_GBR] + j * 1024, P.in[I_GBA] + j * 1024};
#ifndef NO_GGLA
            pg8::gemm_phase<EpiGla>(lds, g, S, E);
#endif
        }
        {
            pg8::Gemm g; pg8::StaticOrder S; EpiPlain E;
            if (kind == 0) { g = pg8::Gemm{HZ, Win_t, Mall, 3072, 1024}; S.init(Mall, 3072, G, bx); E = EpiPlain{BIG, 3072}; }
            else { g = pg8::Gemm{Win_t + (size_t)3072 * 1024, HZ, 1024, Mall, 1024}; S.init(1024, Mall, G, (bx + 64) % G); E = EpiPlain{VTb, (size_t)TT}; }
#ifndef NO_GPLAIN
            pg8::gemm_phase<EpiPlain>(lds, g, S, E);
#endif
        }
        GSYNC();
        const bf16_t* Aout;
        if (kind == 0) {
            conv_phase(BIG, P.in[I_CW] + j * 3 * 1024, HZ, Mres);
            Aout = HZ;
        } else {
#ifndef NO_SCAN
            gla_scan_phase(lds, Qb, Kb, LAb, VTb, HZ, Obb);
#endif
            GSYNC();
            gla_out_phase(HZ, Obb, Rb, P.in[I_GNG] + j * 256, BIG, Mres);
            Aout = BIG;
        }
        GSYNC();
        {
            pg8::Gemm g{Aout, Wout_t, Mres, 1024, 1024}; pg8::StaticOrder S; S.init(Mres, 1024, G, bx);
            EpiRes E{src_lat, src_ctx, Xl, Xc, modl + 2048};
#ifndef NO_GRES
            pg8::gemm_phase<EpiRes>(lds, g, S, E);
#endif
        }
        GSYNC();
        norm_mod_phase(Xl, Xc, P.in[I_N2G] + layer * DM, modl, 3072, 4096, HZ, Mres);
        GSYNC();
        {
            pg8::Gemm g{HZ, Wf1_t, Mres, 5632, 1024}; pg8::StaticOrder S; S.init(Mres, 5632, G, bx);
            EpiSwiglu E{BIG};
#ifndef NO_GSWI
            pg8::gemm_phase<EpiSwiglu>(lds, g, S, E);
#endif
        }
        GSYNC();
        {
            pg8::Gemm g{BIG, Wf2_t, Mres, 1024, 2816}; pg8::StaticOrder S; S.init(Mres, 1024, G, bx);
            EpiRes E{Xl, Xc, Xl, Xc, modl + 5120};
#ifndef NO_GRES
            pg8::gemm_phase<EpiRes>(lds, g, S, E);
#endif
        }
        GSYNC();
    }
    final_norm_phase(Xl, P.in[I_FG], P.out);
}

extern "C" void kernel_launch(void* const* d_in, const int* in_sizes, int n_in, void* d_out, int out_size, void* d_ws, size_t ws_size, hipStream_t stream) {
    static int grid_blocks = 0;
    if (grid_blocks == 0) {
        if (n_in != 21 || ws_size < WS_END) { fprintf(stderr, "kernel_launch: unexpected n_in %d / ws_size %zu (need %zu)\n", n_in, ws_size, (size_t)WS_END); grid_blocks = -1; return; }
        int dev = 0, cus = 0, per_cu = 0;
        hipGetDevice(&dev);
        hipDeviceGetAttribute(&cus, hipDeviceAttributeMultiprocessorCount, dev);
        if (hipFuncSetAttribute((const void*)fwd_megakernel, hipFuncAttributeMaxDynamicSharedMemorySize, LDS_BYTES) != hipSuccess) { fprintf(stderr, "kernel_launch: hipFuncSetAttribute failed\n"); grid_blocks = -1; return; }
        if (hipOccupancyMaxActiveBlocksPerMultiprocessor(&per_cu, (const void*)fwd_megakernel, 512, LDS_BYTES) != hipSuccess || per_cu < 1) { fprintf(stderr, "kernel_launch: occupancy query says %d\n", per_cu); per_cu = 1; }
        (void)hipGetLastError();
        grid_blocks = cus;
    }
    if (grid_blocks < 0) return;
    Params p{};
    for (int i = 0; i < 21; ++i) p.in[i] = (const float*)d_in[i];
    p.out = (float*)d_out; p.ws = (unsigned char*)d_ws;
    void* args[] = {&p};
    hipError_t e = hipLaunchCooperativeKernel((const void*)fwd_megakernel, dim3(grid_blocks), dim3(512), args, LDS_BYTES, stream);
    if (e != hipSuccess) fprintf(stderr, "cooperative launch failed: %s (grid %d)\n", hipGetErrorString(e), grid_blocks);
}
```

```cpp
#include <hip/hip_runtime.h>
#include <hip/hip_cooperative_groups.h>
#include <cstdio>
#include <cstdint>
namespace cg = cooperative_groups;

#define LAS __attribute__((address_space(3)))
typedef unsigned short bf16_t;
typedef short bf16x8 __attribute__((ext_vector_type(8)));
typedef float f32x4 __attribute__((ext_vector_type(4)));
typedef float f32x2 __attribute__((ext_vector_type(2)));
typedef unsigned u32x4 __attribute__((ext_vector_type(4)));
typedef unsigned u32x2 __attribute__((ext_vector_type(2)));

constexpr int DM = 1024, TL = 32768, TC = 4096, TT = TL + TC, DFF = 2816, NCOND = 17, NADA = 6144;
constexpr int LDS_BYTES = 147456;
constexpr size_t MiB = 1u << 20;
constexpr size_t WS_WIN = 0, WS_WOUT = 8 * MiB, WS_WF1 = 10 * MiB, WS_WF2 = 21 * MiB, WS_MOD = 27 * MiB, WS_XCTX = 29 * MiB,
                 WS_HZ = 45 * MiB, WS_BIG = 117 * MiB, WS_R = 333 * MiB, WS_OB = 405 * MiB, WS_W2 = 477 * MiB  , WS_CTL = 504 * MiB, WS_ET = 505 * MiB  , WS_END = 508 * MiB;
constexpr size_t BIG_Q = 0, BIG_K = 36 * MiB, BIG_LA = 72 * MiB, BIG_VT = 144 * MiB;

struct Params { const float* in[21]; float* out; unsigned char* ws; };
enum { I_X = 0, I_C, I_CTX, I_CCTX, I_ADAW, I_ADAB, I_N1G, I_N2G, I_CWIN, I_CW, I_CWOUT, I_GWIN, I_GBR, I_GA1, I_GA2, I_GBA, I_GNG, I_GWOUT, I_FWIN, I_FWOUT, I_FG };

typedef __bf16 bf16x2v __attribute__((ext_vector_type(2)));
__device__ __forceinline__ unsigned cvt_pk_bf16(float lo, float hi) { f32x2 v = {lo, hi}; bf16x2v b = __builtin_convertvector(v, bf16x2v); return __builtin_bit_cast(unsigned, b); }
__device__ __forceinline__ float bf2f(unsigned short b) { return __uint_as_float(((unsigned)b) << 16); }
__device__ __forceinline__ unsigned short f2bf(float f) { return (unsigned short)(cvt_pk_bf16(f, 0.f) & 0xffffu); }
__device__ __forceinline__ float silu_f(float v) { return v * __builtin_amdgcn_rcpf(1.0f + __expf(-v)); }
__device__ __forceinline__ float wave_sum(float v) {
#pragma unroll
    for (int o = 1; o < 64; o <<= 1) v += __shfl_xor(v, o);
    return v;
}
__device__ __forceinline__ int opaque_tid() { int t = threadIdx.x; asm volatile("" : "+v"(t)); return t; }

__device__ __forceinline__ void grid_bar(unsigned* ctr, unsigned target) {
    asm volatile("s_waitcnt vmcnt(0) lgkmcnt(0)" ::: "memory");
    __syncthreads();
    if (threadIdx.x == 0) {
        __builtin_amdgcn_fence(__ATOMIC_RELEASE, "agent");
        asm volatile("s_waitcnt vmcnt(0)" ::: "memory");
        __hip_atomic_fetch_add(ctr, 1u, __ATOMIC_RELAXED, __HIP_MEMORY_SCOPE_AGENT);
        __builtin_amdgcn_fence(__ATOMIC_ACQUIRE, "agent");
        unsigned polls = 0; const unsigned long long t0 = __builtin_amdgcn_s_memrealtime();
        while ((int)(__hip_atomic_load(ctr, __ATOMIC_RELAXED, __HIP_MEMORY_SCOPE_AGENT) - target) < 0) {
            __builtin_amdgcn_s_sleep(1);
            if ((++polls & 255u) == 0u && __builtin_amdgcn_s_memrealtime() - t0 > 200000000ull) break;
        }
        asm volatile("s_waitcnt vmcnt(0)" ::: "memory");
    }
    __syncthreads();
}

#define XB_TMO      128
#define XB_XCNT(j)  (256  + 64 * (j))
#define XB_XSUB(j)  (1280 + 64 * (j))
#define XB_XGEN(j)  (2304 + 64 * (j))
#define XB_TOP      3328
#define XB_TOPGEN   3392
#define XCD_BAR_WORDS 3456
#define XB_SPIN_CAP (1u << 18)
__device__ __forceinline__ unsigned xb_ld(unsigned* p)              { return __hip_atomic_load(p, __ATOMIC_RELAXED, __HIP_MEMORY_SCOPE_AGENT); }
__device__ __forceinline__ unsigned xb_add(unsigned* p, unsigned v) { return __hip_atomic_fetch_add(p, v, __ATOMIC_RELAXED, __HIP_MEMORY_SCOPE_AGENT); }
__device__ __forceinline__ unsigned xb_xcc_id() { return (unsigned)__builtin_amdgcn_s_getreg((3 << 11) | 20) & 0xFu; }
#define XB_SPIN(cond, bar) do { unsigned _sp = 0; while (cond) { __builtin_amdgcn_s_sleep(1); \
    if ((++_sp & 255u) == 0u) { if (xb_ld(&(bar)[XB_TMO])) break; if (_sp > XB_SPIN_CAP) { atomicAdd(&(bar)[XB_TMO], 1u); break; } } } } while (0)
struct XcdBarrier { unsigned* bar; unsigned x; volatile LAS unsigned* st; };
__device__ __forceinline__ XcdBarrier xcd_barrier_post(unsigned* bar, volatile LAS unsigned* st) {
    XcdBarrier b; b.bar = bar; b.x = xb_xcc_id(); b.st = st;
    if (threadIdx.x == 0) (void)xb_add(&bar[XB_XCNT(b.x)], 1u);
    return b;
}
__device__ __forceinline__ void xcd_barrier_complete(unsigned* bar, unsigned x, unsigned& nloc, unsigned& nx) {
    const unsigned G = gridDim.x * gridDim.y * gridDim.z;
    unsigned sum, cnt, mine, sp = 0u;
    for (;;) {
        sum = 0u; cnt = 0u; mine = 0u;
#pragma unroll
        for (unsigned j = 0; j < 16; ++j) { const unsigned c = xb_ld(&bar[XB_XCNT(j)]); sum += c; cnt += (c > 0u) ? 1u : 0u; mine = (j == x) ? c : mine; }
        if (sum == G) break;
        __builtin_amdgcn_s_sleep(1);
        if ((++sp & 255u) == 0u) { if (xb_ld(&bar[XB_TMO])) break; if (sp > XB_SPIN_CAP) { atomicAdd(&bar[XB_TMO], 1u); break; } }
    }
    nloc = mine > 0u ? mine : 1u; nx = cnt > 0u ? cnt : 1u;
}
__device__ __forceinline__ void xcd_barrier(const XcdBarrier& b) {
    asm volatile("s_waitcnt vmcnt(0) lgkmcnt(0)" ::: "memory");
    __syncthreads();
    if (threadIdx.x == 0) {
        unsigned* bar = b.bar;
        __builtin_amdgcn_s_waitcnt(0);
        unsigned nloc = b.st[0], nx = b.st[1];
        if (nloc == 0u) { xcd_barrier_complete(bar, b.x, nloc, nx); b.st[0] = nloc; b.st[1] = nx; }
        const unsigned old = xb_add(&bar[XB_XSUB(b.x)], 1u);
        const unsigned gen = old / nloc;
        if (old + 1u == (gen + 1u) * nloc) {
            __builtin_amdgcn_fence(__ATOMIC_RELEASE, "agent");
            asm volatile("s_waitcnt vmcnt(0)" ::: "memory");
            const unsigned og = xb_add(&bar[XB_TOP], 1u);
            const unsigned tg = og / nx;
            if (og + 1u == (tg + 1u) * nx) xb_add(&bar[XB_TOPGEN], 1u);
            else XB_SPIN(xb_ld(&bar[XB_TOPGEN]) == tg, bar);
            __builtin_amdgcn_fence(__ATOMIC_ACQUIRE, "agent");
            xb_add(&bar[XB_XGEN(b.x)], 1u);
            asm volatile("s_waitcnt vmcnt(0)" ::: "memory");
        } else {
            XB_SPIN(xb_ld(&bar[XB_XGEN(b.x)]) == gen, bar);
            __builtin_amdgcn_fence(__ATOMIC_ACQUIRE, "agent");
            asm volatile("s_waitcnt vmcnt(0)" ::: "memory");
        }
    }
    __syncthreads();
}
#define LDS_WAIT() asm volatile("s_waitcnt lgkmcnt(0)" ::: "memory")

namespace pg8 {
constexpr int BM = 256, BK = 64, HALF = 128, HTB = HALF * BK * 2, STAGE_BYTES = 8 * HTB, NXCD = 8, WGM = 8;
__host__ __device__ __forceinline__ int lds_byte(int r, int c) { const int st = (r >> 4) * 2 + (c >> 5), rr = r & 15, cc = c & 31, ob = rr * 64 + cc * 2; return st * 1024 + (ob ^ (((ob >> 9) & 1) << 5)); }
__host__ __device__ __forceinline__ void stage_rc(int b, int& R, int& C) { const int st = b / 1024, sb = b % 1024, swz = sb ^ (((sb >> 9) & 1) << 5); R = (st >> 1) * 16 + swz / 64; C = (st & 1) * 32 + (swz % 64) / 2; }

__host__ __device__ __forceinline__ int perm32(int rho) { const int n = rho >> 4, i = rho & 15; return 8 * (i >> 2) + 4 * n + (i & 3); }
struct Unit { int pm, pn, k0, nt, part; };
struct Gemm { const bf16_t* A; const bf16_t* Bt; int M, N, K; };

struct StaticOrder {
    int nM, nN, nwg, G, c, ktiles;
    __host__ __device__ void init(int M, int N, int K, int G_, int c_) { nM = M / BM; nN = N / BM; nwg = nM * nN; G = G_; c = c_; ktiles = K / BK; }
    __host__ __device__ __forceinline__ int map(int L) const {
        int wgid = L; { const int q = nwg / NXCD, r = nwg % NXCD, xcd = wgid % NXCD, off = wgid / NXCD; wgid = (xcd < r ? xcd * (q + 1) : r * (q + 1) + (xcd - r) * q) + off; }
        const int nig = WGM * nN, gid = wgid / nig, fm = gid * WGM, gsz = (nM - fm) < WGM ? (nM - fm) : WGM;
        return ((fm + ((wgid % nig) % gsz)) << 16) | ((wgid % nig) / gsz);
    }
    __host__ __device__ __forceinline__ bool next(int i, Unit& u) const {
        const long L = (long)i * G + c; if (L >= nwg) return false;
        const int pp = map((int)L); Unit t; t.pm = pp >> 16; t.pn = pp & 0xffff; t.k0 = 0; t.nt = ktiles; t.part = 0; u = t; return true;
    }
};
struct TailOrder {
    StaticOrder lat; int q, r;
    __host__ __device__ void init(int N, int K, int G_, int c_) { lat.init(TL, N, K, G_, c_); const int kt = K / BK; q = (kt / 4) & ~1; r = kt - 4 * q; }
    __host__ __device__ __forceinline__ bool next(int i, Unit& u) const {
        const long L = (long)i * lat.G + lat.c;
        const int s = (int)(L - lat.nwg); if (s >= 64 * 4) return false;
        const bool whole = L < lat.nwg;
        const int pp = lat.map(whole ? (int)L : 0);
        const int part = s & 3, h2 = r >> 1;
        Unit t;
        t.pm = whole ? (pp >> 16) : TL / BM + (s >> 4); t.pn = whole ? (pp & 0xffff) : ((s >> 2) & 3);
        t.k0 = whole ? 0 : part * q + 2 * (part < h2 ? part : h2); t.nt = whole ? lat.ktiles : q + (part < h2 ? 2 : 0); t.part = whole ? 0 : part;
        u = t; return true;
    }
};

template <class Epi, class Sched = StaticOrder, bool ALIGN_EPI = true>
__device__ __forceinline__ void gemm_phase(LAS unsigned char* lds, const Gemm g, const Sched& S, const Epi& E) {
    const int tid = opaque_tid(), wid = __builtin_amdgcn_readfirstlane(tid >> 6), lane = tid & 63, wr = wid >> 2, wc = wid & 3, fr = lane & 15, fq = lane >> 4;
    const int K = g.K;
    unsigned voffA[2], voffB[2];
#pragma unroll
    for (int i = 0; i < 2; ++i) { int R, C; stage_rc(tid * 16 + i * 8192, R, C); const int Rb = (R & ~31) + perm32(R & 31); voffA[i] = (unsigned)(R * K + C) * 2u; voffB[i] = (unsigned)(Rb * K + C) * 2u; }
    const size_t kstep = (size_t)(BK * 2);
    const size_t hstep = (size_t)HALF * K * 2;
    const size_t tstep = 2 * hstep;
    const unsigned ldsw = (unsigned)wid * 1024u;
    const int aoff = lds_byte(wr * 64 + fr, fq * 8), boff = lds_byte(wc * 32 + fr, fq * 8);
#define PG8_SA(b, h) (((b) * 2 + (h)) * HTB)
#define PG8_SB(b, h) ((4 + (b) * 2 + (h)) * HTB)
#define PG8_STAGE(bufoff, gbase, voff) do { _Pragma("unroll") for (int _i = 0; _i < 2; ++_i) \
        __builtin_amdgcn_global_load_lds((const unsigned*)((const char*)(gbase) + (voff)[_i]), (LAS unsigned*)(lds + (bufoff) + ldsw + _i * 8192), 16, 0, 0); } while (0)
#define PG8_LDA(dst, b, h) do { _Pragma("unroll") for (int m = 0; m < 4; ++m) _Pragma("unroll") for (int k = 0; k < 2; ++k) dst[m][k] = *(const LAS bf16x8*)(lds + PG8_SA(b, h) + aoff + m * 2048 + k * 1024); } while (0)
#define PG8_LDB(dst, b, h) do { _Pragma("unroll") for (int n = 0; n < 2; ++n) _Pragma("unroll") for (int k = 0; k < 2; ++k) dst[n][k] = *(const LAS bf16x8*)(lds + PG8_SB(b, h) + boff + n * 2048 + k * 1024); } while (0)
#define PG8_MMA(ai, bj, At, Bt) do { __builtin_amdgcn_s_setprio(1); _Pragma("unroll") for (int m = 0; m < 4; ++m) _Pragma("unroll") for (int n = 0; n < 2; ++n) _Pragma("unroll") for (int k = 0; k < 2; ++k) \
        acc[ai][bj][m][n] = __builtin_amdgcn_mfma_f32_16x16x32_bf16(Bt[n][k], At[m][k], acc[ai][bj][m][n], 0, 0, 0); __builtin_amdgcn_s_setprio(0); } while (0)
#define PG8_WAIT_V(n) asm volatile("s_waitcnt vmcnt(" #n ")" ::: "memory")
#define PG8_WAIT_L(n) asm volatile("s_waitcnt lgkmcnt(" #n ")" ::: "memory")
#define PG8_BAR __builtin_amdgcn_s_barrier()
#define PG8_SCHED __builtin_amdgcn_sched_barrier(0)
    Unit cur, nxt; int ui = 0;
    if (!S.next(0, cur)) return;
    f32x4 acc[2][2][4][2];
#pragma unroll
    for (int a = 0; a < 2; ++a)
#pragma unroll
        for (int b = 0; b < 2; ++b)
#pragma unroll
            for (int m = 0; m < 4; ++m)
#pragma unroll
                for (int n = 0; n < 2; ++n) acc[a][b][m][n] = (f32x4){0.f, 0.f, 0.f, 0.f};
    bf16x8 At[4][2], B0[2][2], B1[2][2];
    const char* cA = (const char*)g.A + (size_t)cur.pm * tstep + (size_t)cur.k0 * kstep; const char* cB = (const char*)g.Bt + (size_t)cur.pn * tstep + (size_t)cur.k0 * kstep;
    PG8_STAGE(PG8_SB(0, 0), cB, voffB); PG8_STAGE(PG8_SB(0, 1), cB + hstep, voffB); PG8_STAGE(PG8_SA(0, 0), cA, voffA); PG8_STAGE(PG8_SA(0, 1), cA + hstep, voffA);
    if (wr == 1) PG8_BAR;
    PG8_WAIT_V(2); PG8_BAR;
    PG8_STAGE(PG8_SB(1, 0), cB + kstep, voffB); PG8_STAGE(PG8_SA(1, 0), cA + kstep, voffA); PG8_STAGE(PG8_SB(1, 1), cB + hstep + kstep, voffB);
    PG8_WAIT_V(6); PG8_BAR;
    for (;;) {
        const bool has_next = S.next(ui + 1, nxt);
        const char* nA = has_next ? (const char*)g.A + (size_t)nxt.pm * tstep + (size_t)nxt.k0 * kstep : cA; const char* nB = has_next ? (const char*)g.Bt + (size_t)nxt.pn * tstep + (size_t)nxt.k0 * kstep : cB;
        const int nt = cur.nt;
        for (int t = 0; t < nt; t += 2) {
            const bool last = (t == nt - 2);
            const char* a1 = cA + (size_t)(t + 1) * kstep;
            const char* a2 = last ? nA : cA + (size_t)(t + 2) * kstep; const char* b2 = last ? nB : cB + (size_t)(t + 2) * kstep;
            const char* a3 = a2 + kstep; const char* b3 = b2 + kstep;
            PG8_LDB(B0, 0, 0); PG8_LDB(B1, 0, 1); PG8_SCHED; PG8_LDA(At, 0, 0); PG8_STAGE(PG8_SA(1, 1), a1 + hstep, voffA);
            PG8_WAIT_V(8); PG8_WAIT_L(0); PG8_BAR; PG8_MMA(0, 0, At, B0); PG8_MMA(0, 1, At, B1); PG8_BAR; PG8_SCHED;
            PG8_LDA(At, 0, 1); PG8_STAGE(PG8_SB(0, 0), b2, voffB); PG8_STAGE(PG8_SB(0, 1), b2 + hstep, voffB); PG8_STAGE(PG8_SA(0, 0), a2, voffA);
            PG8_WAIT_V(8); PG8_WAIT_L(0); PG8_BAR; PG8_MMA(1, 0, At, B0); PG8_MMA(1, 1, At, B1); PG8_BAR; PG8_SCHED;
            PG8_LDB(B0, 1, 0); PG8_LDB(B1, 1, 1); PG8_SCHED; PG8_LDA(At, 1, 0); PG8_STAGE(PG8_SA(0, 1), a2 + hstep, voffA);
            PG8_WAIT_V(8); PG8_WAIT_L(0); PG8_BAR; PG8_MMA(0, 0, At, B0); PG8_MMA(0, 1, At, B1); PG8_BAR; PG8_SCHED;
            PG8_LDA(At, 1, 1); PG8_STAGE(PG8_SB(1, 0), b3, voffB); PG8_STAGE(PG8_SB(1, 1), b3 + hstep, voffB); PG8_STAGE(PG8_SA(1, 0), a3, voffA);
            PG8_WAIT_V(8); PG8_WAIT_L(0); PG8_BAR; PG8_MMA(1, 0, At, B0); PG8_MMA(1, 1, At, B1); PG8_BAR; PG8_SCHED;
        }
        if constexpr (ALIGN_EPI) { if (wr == 0) PG8_BAR; }
        E(acc, cur, wr, wc, fr, fq);
        if (!has_next) break;
#pragma unroll
        for (int a = 0; a < 2; ++a)
#pragma unroll
            for (int b = 0; b < 2; ++b)
#pragma unroll
                for (int m = 0; m < 4; ++m)
#pragma unroll
                    for (int n = 0; n < 2; ++n) acc[a][b][m][n] = (f32x4){0.f, 0.f, 0.f, 0.f};
        cur = nxt; cA = nA; cB = nB; ++ui;
        if constexpr (ALIGN_EPI) { if (wr == 1) PG8_BAR; }
    }
    PG8_WAIT_V(0);
    if constexpr (!ALIGN_EPI) { if (wr == 0) PG8_BAR; }
    PG8_BAR;
#undef PG8_SA
#undef PG8_SB
#undef PG8_STAGE
#undef PG8_LDA
#undef PG8_LDB
#undef PG8_MMA
#undef PG8_WAIT_V
#undef PG8_WAIT_L
#undef PG8_BAR
#undef PG8_SCHED
}
}
using pg8::Unit;
typedef f32x4 AccT[2][2][4][2];

#define PACK8(v0, v1) (u32x4){cvt_pk_bf16((v0)[0], (v0)[1]), cvt_pk_bf16((v0)[2], (v0)[3]), cvt_pk_bf16((v1)[0], (v1)[1]), cvt_pk_bf16((v1)[2], (v1)[3])}
struct EpiPlain {
    bf16_t* O; size_t ldc;
    __device__ __forceinline__ void operator()(const AccT& acc, const Unit& u, int wr, int wc, int fr, int fq) const {
        const int row0 = u.pm * 256 + wr * 64 + fr, col0 = u.pn * 256 + wc * 32 + 8 * fq;
#pragma unroll
        for (int ai = 0; ai < 2; ++ai)
#pragma unroll
            for (int m = 0; m < 4; ++m) { bf16_t* rowp = O + (size_t)(row0 + ai * 128 + m * 16) * ldc + col0;
#pragma unroll
                for (int bj = 0; bj < 2; ++bj) *(u32x4*)(rowp + bj * 128) = PACK8(acc[ai][bj][m][0], acc[ai][bj][m][1]); }
    }
};
struct EpiGla {
    bf16_t *QDf, *KIf, *QDb, *KIb, *R; float* ET; const float *b_r, *b_a;
    __device__ __forceinline__ void operator()(const AccT& acc, const Unit& u, int wr, int wc, int fr, int fq) const {
        const int row0 = u.pm * 256 + wr * 64 + fr;
        const int pn = u.pn;
        if (pn < 8) {
            const int d0 = 64 * pn + 16 * wc + 4 * fq;
            const f32x4 baf = *(const f32x4*)(b_a + d0), bab = *(const f32x4*)(b_a + 512 + d0);
#pragma unroll
            for (int ai = 0; ai < 2; ++ai) {
                f32x4 pf[4], pb[4];
#pragma unroll
                for (int m = 0; m < 4; ++m) {
                    const f32x4 xf = acc[ai][1][m][0] + baf, xb = acc[ai][1][m][1] + bab;
#pragma unroll
                    for (int j = 0; j < 4; ++j) { pf[m][j] = (fminf(xf[j], 0.f) - __logf(1.0f + __expf(-fabsf(xf[j])))) * 0.0625f; pb[m][j] = (fminf(xb[j], 0.f) - __logf(1.0f + __expf(-fabsf(xb[j])))) * 0.0625f; }
                }
                f32x4 lb[4];
#pragma unroll
                for (int m = 0; m < 4; ++m) lb[m] = pb[m];
#pragma unroll
                for (int dl = 1; dl < 16; dl <<= 1) {
#pragma unroll
                    for (int m = 0; m < 4; ++m)
#pragma unroll
                        for (int j = 0; j < 4; ++j) { const float tf = __shfl_up(pf[m][j], dl, 16), tb = __shfl_up(pb[m][j], dl, 16); if (fr >= dl) { pf[m][j] += tf; pb[m][j] += tb; } }
                }
                f32x4 of = (f32x4){0.f, 0.f, 0.f, 0.f}, ob = of;
#pragma unroll
                for (int m = 0; m < 4; ++m)
#pragma unroll
                    for (int j = 0; j < 4; ++j) { const float tf = __shfl(pf[m][j], 15, 16), tb = __shfl(pb[m][j], 15, 16); pf[m][j] += of[j]; pb[m][j] += ob[j]; of[j] += tf; ob[j] += tb; }
                const int rbase = row0 + ai * 128;
                if (fr == 0) { const int chunk = (u.pm * 256 + ai * 128 + wr * 64) >> 6; f32x4 e0, e1;
#pragma unroll
                    for (int j = 0; j < 4; ++j) { e0[j] = __expf(of[j]); e1[j] = __expf(ob[j]); }
                    *(f32x4*)(ET + ((size_t)chunk * 2 + 0) * 512 + d0) = e0; *(f32x4*)(ET + ((size_t)chunk * 2 + 1) * 512 + d0) = e1; }
#pragma unroll
                for (int m = 0; m < 4; ++m) {
                    const f32x4 q = acc[ai][0][m][0] * 0.08838834764831845f, k = acc[ai][0][m][1];
                    f32x4 qf, kf, qb, kb;
#pragma unroll
                    for (int j = 0; j < 4; ++j) { const float bfw = pf[m][j], bbw = ob[j] - pb[m][j] + lb[m][j];
                        const float ef = __expf(bfw), eb = __expf(bbw);
                        qf[j] = q[j] * ef; kf[j] = k[j] * __builtin_amdgcn_rcpf(ef); qb[j] = q[j] * eb; kb[j] = k[j] * __builtin_amdgcn_rcpf(eb); }
                    const size_t off = (size_t)(rbase + m * 16) * 512 + d0;
                    u32x2 w;
                    w.x = cvt_pk_bf16(qf[0], qf[1]); w.y = cvt_pk_bf16(qf[2], qf[3]); *(u32x2*)(QDf + off) = w;
                    w.x = cvt_pk_bf16(kf[0], kf[1]); w.y = cvt_pk_bf16(kf[2], kf[3]); *(u32x2*)(KIf + off) = w;
                    w.x = cvt_pk_bf16(qb[0], qb[1]); w.y = cvt_pk_bf16(qb[2], qb[3]); *(u32x2*)(QDb + off) = w;
                    w.x = cvt_pk_bf16(kb[0], kb[1]); w.y = cvt_pk_bf16(kb[2], kb[3]); *(u32x2*)(KIb + off) = w;
                }
            }
        } else {
            const int col0 = (pn - 8) * 256 + wc * 32 + 8 * fq;
            f32x4 bv[2][2];
#pragma unroll
            for (int bj = 0; bj < 2; ++bj)
#pragma unroll
                for (int n = 0; n < 2; ++n) bv[bj][n] = *(const f32x4*)(b_r + col0 + bj * 128 + n * 4);
#pragma unroll
            for (int ai = 0; ai < 2; ++ai)
#pragma unroll
                for (int m = 0; m < 4; ++m) { bf16_t* rowp = R + (size_t)(row0 + ai * 128 + m * 16) * 1024 + col0;
#pragma unroll
                    for (int bj = 0; bj < 2; ++bj) { f32x4 v0 = acc[ai][bj][m][0] + bv[bj][0], v1 = acc[ai][bj][m][1] + bv[bj][1];
#pragma unroll
                        for (int j = 0; j < 4; ++j) { v0[j] = silu_f(v0[j]); v1[j] = silu_f(v1[j]); }
                        *(u32x4*)(rowp + bj * 128) = PACK8(v0, v1); } }
        }
    }
};
struct EpiDelta {
    bf16_t* D; const float* gate; bf16_t* Dp; int split;
    __device__ __forceinline__ void operator()(const AccT& acc, const Unit& u, int wr, int wc, int fr, int fq) const {
        const int rt = u.pm * 256; const int b = rt >= TL ? 16 : (rt >> 11);
        const int colt = u.pn * 256 + wc * 32 + 8 * fq;
        const float* gp = gate + (size_t)b * NADA + colt;
        f32x4 gv[2][2];
#pragma unroll
        for (int bj = 0; bj < 2; ++bj)
#pragma unroll
            for (int n = 0; n < 2; ++n) gv[bj][n] = *(const f32x4*)(gp + bj * 128 + n * 4);
#pragma unroll
        for (int ai = 0; ai < 2; ++ai)
#pragma unroll
            for (int m = 0; m < 4; ++m) { bf16_t* rowp = (split && rt >= TL ? Dp + (size_t)u.part * TC * DM + (size_t)(rt - TL + wr * 64 + fr + ai * 128 + m * 16) * DM : D + (size_t)(rt + wr * 64 + fr + ai * 128 + m * 16) * DM) + colt;
#pragma unroll
                for (int bj = 0; bj < 2; ++bj) { const f32x4 v0 = gv[bj][0] * acc[ai][bj][m][0], v1 = gv[bj][1] * acc[ai][bj][m][1]; *(u32x4*)(rowp + bj * 128) = PACK8(v0, v1); } }
    }
};
struct EpiConvIn {
    bf16_t* PU;
    __device__ __forceinline__ void operator()(const AccT& acc, const Unit& u, int wr, int wc, int fr, int fq) const {
        const int row0 = u.pm * 256 + wr * 64 + fr;
        if (u.pn < 4) {
            const int col0 = u.pn * 256 + wc * 32 + 8 * fq;
#pragma unroll
            for (int ai = 0; ai < 2; ++ai)
#pragma unroll
                for (int m = 0; m < 4; ++m) { bf16_t* rowp = PU + (size_t)(row0 + ai * 128 + m * 16) * 2048 + col0;
#pragma unroll
                    for (int bj = 0; bj < 2; ++bj) *(u32x4*)(rowp + bj * 128) = PACK8(acc[ai][bj][m][0], acc[ai][bj][m][1]); }
        } else {
            const int col0 = 1024 + (u.pn - 4) * 128 + wc * 32 + 8 * fq;
#pragma unroll
            for (int ai = 0; ai < 2; ++ai)
#pragma unroll
                for (int m = 0; m < 4; ++m) { bf16_t* rowp = PU + (size_t)(row0 + ai * 128 + m * 16) * 2048 + col0;
                    const f32x4 v0 = acc[ai][0][m][0] * acc[ai][1][m][0], v1 = acc[ai][0][m][1] * acc[ai][1][m][1];
                    *(u32x4*)(rowp) = PACK8(v0, v1); }
        }
    }
};
struct EpiSwiglu {
    bf16_t* F;
    __device__ __forceinline__ void operator()(const AccT& acc, const Unit& u, int wr, int wc, int fr, int fq) const {
        const int row0 = u.pm * 256 + wr * 64 + fr, col0 = u.pn * 128 + wc * 32 + 8 * fq;
#pragma unroll
        for (int ai = 0; ai < 2; ++ai)
#pragma unroll
            for (int m = 0; m < 4; ++m) { bf16_t* rowp = F + (size_t)(row0 + ai * 128 + m * 16) * DFF + col0;
                f32x4 v0, v1;
#pragma unroll
                for (int j = 0; j < 4; ++j) { v0[j] = silu_f(acc[ai][0][m][0][j]) * acc[ai][1][m][0][j]; v1[j] = silu_f(acc[ai][0][m][1][j]) * acc[ai][1][m][1][j]; }
                *(u32x4*)(rowp) = PACK8(v0, v1); }
    }
};

__device__ __forceinline__ void ada_phase(LAS unsigned char* lds, const Params& P) {
    LAS float* sc = (LAS float*)lds;
    LAS float* red = sc + NCOND * 1024;
    const int tid = opaque_tid(), wave = tid >> 6, lane = tid & 63;
    const float* c = P.in[I_C]; const float* cctx = P.in[I_CCTX]; const float* adaw = P.in[I_ADAW]; const float* adab = P.in[I_ADAB];
    float* mod = (float*)(P.ws + WS_MOD);
    if ((int)blockIdx.x >= 192) return;
    for (int idx = tid; idx < NCOND * 1024; idx += 512) { const int b = idx >> 10, k = idx & 1023; const float v = b < 16 ? c[b * 1024 + k] : cctx[k]; sc[idx] = silu_f(v); }
    __syncthreads();
    for (int item = blockIdx.x; item < 192; item += gridDim.x) {
        const int l = item / 48, n0 = (item % 48) * 128;
        float acc[NCOND][2];
#pragma unroll
        for (int b = 0; b < NCOND; ++b) { acc[b][0] = 0.f; acc[b][1] = 0.f; }
        const float* wbase = adaw + ((size_t)l * 1024) * NADA + n0 + 2 * lane;
        for (int k = 128 * wave; k < 128 * wave + 128; k += 16) {
            f32x2 wv[16];
#pragma unroll
            for (int i = 0; i < 16; ++i) wv[i] = __builtin_nontemporal_load((const f32x2*)(wbase + (size_t)(k + i) * NADA));
#pragma unroll
            for (int b = 0; b < NCOND; ++b) {
#pragma unroll
                for (int kk = 0; kk < 16; kk += 4) { const f32x4 s4 = *(const LAS f32x4*)(sc + b * 1024 + k + kk);
                    acc[b][0] += s4[0] * wv[kk][0] + s4[1] * wv[kk + 1][0] + s4[2] * wv[kk + 2][0] + s4[3] * wv[kk + 3][0];
                    acc[b][1] += s4[0] * wv[kk][1] + s4[1] * wv[kk + 1][1] + s4[2] * wv[kk + 2][1] + s4[3] * wv[kk + 3][1]; } }
        }
#pragma unroll
        for (int b = 0; b < NCOND; ++b) { red[(wave * NCOND + b) * 128 + 2 * lane] = acc[b][0]; red[(wave * NCOND + b) * 128 + 2 * lane + 1] = acc[b][1]; }
        __syncthreads();
        for (int idx = tid; idx < NCOND * 128; idx += 512) { const int b = idx >> 7, cc = idx & 127; float s = 0.f;
#pragma unroll
            for (int w = 0; w < 8; ++w) s += red[(w * NCOND + b) * 128 + cc];
            mod[((size_t)l * NCOND + b) * NADA + n0 + cc] = s + adab[l * NADA + n0 + cc]; }
        __syncthreads();
    }
}

__host__ __device__ __forceinline__ int qkl_row(int type, int d) { return 256 * (d >> 6) + 128 * (type >> 1) + 32 * ((d >> 4) & 3) + 8 * ((d >> 2) & 3) + 4 * (type & 1) + (d & 3); }
__device__ __forceinline__ void transpose_item(const float* W, int K, int N, bf16_t* WT, int wt_row0, int k0, int n0, LAS float* scr, int lane, int qkl_type = -1) {
#pragma unroll 8
    for (int i = 0; i < 32; ++i) { const int kk = 2 * i + (lane >> 5); scr[kk * 33 + (lane & 31)] = __builtin_nontemporal_load(W + (size_t)(k0 + kk) * N + n0 + (lane & 31)); }
    LDS_WAIT(); asm volatile("" ::: "memory");
    const int c = lane & 7;
#pragma unroll
    for (int j = 0; j < 4; ++j) { const int n = (lane >> 3) + 8 * j; const LAS float* s = scr + (8 * c) * 33 + n;
        u32x4 o; o.x = cvt_pk_bf16(s[0 * 33], s[1 * 33]); o.y = cvt_pk_bf16(s[2 * 33], s[3 * 33]); o.z = cvt_pk_bf16(s[4 * 33], s[5 * 33]); o.w = cvt_pk_bf16(s[6 * 33], s[7 * 33]);
        const int drow = qkl_type >= 0 ? qkl_row(qkl_type, wt_row0 + n) : wt_row0 + n;
        *(u32x4*)(WT + (size_t)drow * K + k0 + 8 * c) = o; }
    LDS_WAIT(); asm volatile("" ::: "memory");
}
__device__ __forceinline__ void prep_layer(LAS unsigned char* lds, const Params& P, int layer, int c0, int nblk) {
    const int tid = opaque_tid(), wave = tid >> 6, lane = tid & 63;
    const int kind = layer & 1, j = layer >> 1;
    LAS float* scr = (LAS float*)(lds + wave * 8704);
    unsigned char* wb = P.ws + ((layer & 1) ? WS_W2 : 0);
    bf16_t* Win_t = (bf16_t*)(wb + WS_WIN); bf16_t* Wout_t = (bf16_t*)(wb + WS_WOUT); bf16_t* Wf1_t = (bf16_t*)(wb + WS_WF1); bf16_t* Wf2_t = (bf16_t*)(wb + WS_WF2);
    const float* Win = (kind == 0 ? P.in[I_CWIN] : P.in[I_GWIN]) + (size_t)j * 1024 * 3072;
    const float* Wout = (kind == 0 ? P.in[I_CWOUT] : P.in[I_GWOUT]) + (size_t)j * 1024 * 1024;
    const float* Wf1 = P.in[I_FWIN] + (size_t)layer * 1024 * 5632;
    const float* Wf2 = P.in[I_FWOUT] + (size_t)layer * 2816 * 1024;
    const int gw = ((int)blockIdx.x - c0) * 8 + wave, NGW = nblk * 8;
    for (int it = gw; it < 6272; it += NGW) {
        if (it < 1536) { const int kb = it / 96, n0 = (it % 96) * 32;
            if (kind == 0) { const int row0 = n0 < 1024 ? n0 : (n0 < 2048 ? 1024 + 256 * ((n0 - 1024) / 128) + ((n0 - 1024) % 128) : 1024 + 256 * ((n0 - 2048) / 128) + 128 + ((n0 - 2048) % 128));
                transpose_item(Win, 1024, 3072, Win_t, row0, kb * 64, n0, scr, lane); }
            else if (n0 < 1024) transpose_item(Win, 1024, 3072, Win_t, n0 & 511, kb * 64, n0, scr, lane, n0 >> 9);
            else transpose_item(Win, 1024, 3072, Win_t, n0 < 2048 ? n0 + 2048 : n0, kb * 64, n0, scr, lane); }
        else if (it < 2048) { const int r = it - 1536; const int kb = r / 32, n0 = (r % 32) * 32; transpose_item(Wout, 1024, 1024, Wout_t, n0, kb * 64, n0, scr, lane); }
        else if (it < 4864) { const int r = it - 2048; const int kb = r / 176, n0 = (r % 176) * 32;
            const int row0 = n0 < 2816 ? 256 * (n0 / 128) + (n0 % 128) : 256 * ((n0 - 2816) / 128) + 128 + ((n0 - 2816) % 128);
            transpose_item(Wf1, 1024, 5632, Wf1_t, row0, kb * 64, n0, scr, lane); }
        else { const int r = it - 4864; const int kb = r / 32, n0 = (r % 32) * 32; transpose_item(Wf2, 2816, 1024, Wf2_t, n0, kb * 64, n0, scr, lane); }
    }
    if (kind == 1) {
        const float* a1 = P.in[I_GA1] + (size_t)j * 2 * 1024 * 16; const float* a2 = P.in[I_GA2] + (size_t)j * 2 * 16 * 512;
        const int gt = ((int)blockIdx.x - c0) * 512 + tid, NT = nblk * 512;
        for (int idx = gt; idx < 1024 * 128; idx += NT) {
            const int row = idx >> 7, kg = idx & 127, dir = row >> 9, d = row & 511;
            float a2v[16];
#pragma unroll
            for (int r = 0; r < 16; ++r) a2v[r] = a2[((size_t)dir * 16 + r) * 512 + d];
            float o[8];
#pragma unroll
            for (int kk = 0; kk < 8; ++kk) { const f32x4* ar = (const f32x4*)(a1 + ((size_t)dir * 1024 + 8 * kg + kk) * 16); float s = 0.f;
#pragma unroll
                for (int q = 0; q < 4; ++q) { const f32x4 av = ar[q]; s += av[0] * a2v[4 * q] + av[1] * a2v[4 * q + 1] + av[2] * a2v[4 * q + 2] + av[3] * a2v[4 * q + 3]; }
                o[kk] = s; }
            u32x4 w; w.x = cvt_pk_bf16(o[0], o[1]); w.y = cvt_pk_bf16(o[2], o[3]); w.z = cvt_pk_bf16(o[4], o[5]); w.w = cvt_pk_bf16(o[6], o[7]);
            *(u32x4*)(Win_t + (size_t)qkl_row(2 + dir, d) * 1024 + 8 * kg) = w;
        }
    }
}

__device__ __forceinline__ void norm_mod_phase(const float* src_lat, const float* src_ctx, const bf16_t* delta, const bf16_t* dparts, float* xo_lat, float* xo_ctx,
                                               const float* gain, const float* modl, int shoff, int scoff, bf16_t* H, int nrows) {
    const int tid = opaque_tid(), wave = tid >> 6, lane = tid & 63;
    const int gw = blockIdx.x * 8 + wave, NGW = gridDim.x * 8;
    for (int r0 = gw * 4; r0 < nrows; r0 += NGW * 4) {
        const float* xrow = r0 < TL ? src_lat + (size_t)r0 * DM : src_ctx + (size_t)(r0 - TL) * DM; const int b = r0 < TL ? (r0 >> 11) : 16;
        float* xout = r0 < TL ? xo_lat + (size_t)r0 * DM : xo_ctx + (size_t)(r0 - TL) * DM;
        f32x4 v[4][4]; float ss[4];
#pragma unroll
        for (int i = 0; i < 4; ++i)
#pragma unroll
            for (int q = 0; q < 4; ++q) v[i][q] = __builtin_nontemporal_load((const f32x4*)(xrow + (size_t)i * DM) + lane + 64 * q);
        if (delta) {
            const int np = (dparts && r0 >= TL) ? 4 : 1;
            for (int p = 0; p < np; ++p) {
                const bf16_t* dsrc = np == 4 ? dparts + (size_t)p * TC * DM + (size_t)(r0 - TL) * DM : delta + (size_t)r0 * DM;
                u32x2 dv[4][4];
#pragma unroll
                for (int i = 0; i < 4; ++i)
#pragma unroll
                    for (int q = 0; q < 4; ++q) dv[i][q] = __builtin_nontemporal_load((const u32x2*)(dsrc + (size_t)i * DM + 4 * lane + 256 * q));
#pragma unroll
                for (int i = 0; i < 4; ++i)
#pragma unroll
                    for (int q = 0; q < 4; ++q) { v[i][q][0] += bf2f((unsigned short)(dv[i][q].x & 0xffff)); v[i][q][1] += bf2f((unsigned short)(dv[i][q].x >> 16));
                        v[i][q][2] += bf2f((unsigned short)(dv[i][q].y & 0xffff)); v[i][q][3] += bf2f((unsigned short)(dv[i][q].y >> 16)); }
            }
        }
#pragma unroll
        for (int i = 0; i < 4; ++i)
#pragma unroll
            for (int q = 0; q < 4; ++q) { if (xo_lat) __builtin_nontemporal_store(v[i][q], (f32x4*)(xout + (size_t)i * DM) + lane + 64 * q); }
        const float* mb = modl + (size_t)b * NADA;
        f32x4 g4[4], sc4[4], sh4[4];
#pragma unroll
        for (int q = 0; q < 4; ++q) { const int col = 4 * lane + 256 * q; g4[q] = *(const f32x4*)(gain + col); sc4[q] = *(const f32x4*)(mb + scoff + col) + 1.0f; sh4[q] = *(const f32x4*)(mb + shoff + col); }
#pragma unroll
        for (int i = 0; i < 4; ++i) { float s = 0.f;
#pragma unroll
            for (int q = 0; q < 4; ++q) s += (v[i][q][0] * v[i][q][0] + v[i][q][1] * v[i][q][1]) + (v[i][q][2] * v[i][q][2] + v[i][q][3] * v[i][q][3]);
            ss[i] = s; }
#pragma unroll
        for (int o = 1; o < 64; o <<= 1) {
#pragma unroll
            for (int i = 0; i < 4; ++i) ss[i] += __shfl_xor(ss[i], o); }
#pragma unroll
        for (int i = 0; i < 4; ++i) { const float rstd = rsqrtf(ss[i] * (1.0f / DM) + 1e-6f);
#pragma unroll
            for (int q = 0; q < 4; ++q) { const int col = 4 * lane + 256 * q; const f32x4 h = (v[i][q] * rstd * g4[q]) * sc4[q] + sh4[q];
                u32x2 w; w.x = cvt_pk_bf16(h[0], h[1]); w.y = cvt_pk_bf16(h[2], h[3]); *(u32x2*)(H + (size_t)(r0 + i) * DM + col) = w; } }
    }
}
__device__ __forceinline__ void final_norm_phase(const float* X, const bf16_t* delta, const float* gain, float* out) {
    const int tid = opaque_tid(), wave = tid >> 6, lane = tid & 63;
    const int gw = blockIdx.x * 8 + wave, NGW = gridDim.x * 8;
    for (int r0 = gw * 4; r0 < TL; r0 += NGW * 4) {
        f32x4 v[4][4]; float ss[4]; u32x2 dv[4][4];
#pragma unroll
        for (int i = 0; i < 4; ++i)
#pragma unroll
            for (int q = 0; q < 4; ++q) { v[i][q] = __builtin_nontemporal_load((const f32x4*)(X + (size_t)(r0 + i) * DM) + lane + 64 * q); dv[i][q] = __builtin_nontemporal_load((const u32x2*)(delta + (size_t)(r0 + i) * DM + 4 * lane + 256 * q)); }
        f32x4 g4[4];
#pragma unroll
        for (int q = 0; q < 4; ++q) g4[q] = *(const f32x4*)(gain + 4 * lane + 256 * q);
#pragma unroll
        for (int i = 0; i < 4; ++i) { float s = 0.f;
#pragma unroll
            for (int q = 0; q < 4; ++q) { v[i][q][0] += bf2f((unsigned short)(dv[i][q].x & 0xffff)); v[i][q][1] += bf2f((unsigned short)(dv[i][q].x >> 16));
                v[i][q][2] += bf2f((unsigned short)(dv[i][q].y & 0xffff)); v[i][q][3] += bf2f((unsigned short)(dv[i][q].y >> 16));
                s += (v[i][q][0] * v[i][q][0] + v[i][q][1] * v[i][q][1]) + (v[i][q][2] * v[i][q][2] + v[i][q][3] * v[i][q][3]); }
            ss[i] = s; }
#pragma unroll
        for (int o = 1; o < 64; o <<= 1) {
#pragma unroll
            for (int i = 0; i < 4; ++i) ss[i] += __shfl_xor(ss[i], o); }
#pragma unroll
        for (int i = 0; i < 4; ++i) { const float rstd = rsqrtf(ss[i] * (1.0f / DM) + 1e-6f);
#pragma unroll
            for (int q = 0; q < 4; ++q) __builtin_nontemporal_store(v[i][q] * rstd * g4[q], (f32x4*)(out + (size_t)(r0 + i) * DM + 4 * lane + 256 * q)); }
    }
}
__device__ __forceinline__ void conv_phase(const bf16_t* PU, const float* cw, bf16_t* Z, int ntok) {
    const int gt = blockIdx.x * 512 + opaque_tid(), NT = gridDim.x * 512;
    const int total = (ntok >> 3) * 128;
    for (int idx = gt; idx < total; idx += NT) {
        const int t0 = (idx >> 7) * 8, cg8 = (idx & 127) * 8;
        int pos0, len; if (t0 < TL) { pos0 = t0 & 63; len = 64; } else { pos0 = (t0 - TL) & 255; len = 256; }
        const bf16_t* row = PU + (size_t)t0 * 2048 + cg8;
        const bool hasp = pos0 > 0, hasn = pos0 + 8 < len;
        u32x4 gbv[8], uv[10];
        const u32x4 z4 = (u32x4){0, 0, 0, 0};
        uv[0] = z4; uv[9] = z4;
        if (hasp) uv[0] = __builtin_nontemporal_load((const u32x4*)(row - 2048 + 1024));
#pragma unroll
        for (int i = 0; i < 8; ++i) { gbv[i] = __builtin_nontemporal_load((const u32x4*)(row + (size_t)i * 2048)); uv[i + 1] = __builtin_nontemporal_load((const u32x4*)(row + (size_t)i * 2048 + 1024)); }
        if (hasn) uv[9] = __builtin_nontemporal_load((const u32x4*)(row + (size_t)8 * 2048 + 1024));
        float w0[8], w1[8], w2[8];
#pragma unroll
        for (int e = 0; e < 8; ++e) { w0[e] = cw[cg8 + e]; w1[e] = cw[1024 + cg8 + e]; w2[e] = cw[2048 + cg8 + e]; }
#pragma unroll
        for (int i = 0; i < 8; ++i) {
            float o[8];
#pragma unroll
            for (int q = 0; q < 4; ++q) {
                const float gb0 = bf2f((unsigned short)(gbv[i][q] & 0xffff)), gb1 = bf2f((unsigned short)(gbv[i][q] >> 16));
                const float p0 = bf2f((unsigned short)(uv[i][q] & 0xffff)), p1 = bf2f((unsigned short)(uv[i][q] >> 16));
                const float c0 = bf2f((unsigned short)(uv[i + 1][q] & 0xffff)), c1 = bf2f((unsigned short)(uv[i + 1][q] >> 16));
                const float n0 = bf2f((unsigned short)(uv[i + 2][q] & 0xffff)), n1 = bf2f((unsigned short)(uv[i + 2][q] >> 16));
                o[2 * q] = gb0 * (w0[2 * q] * p0 + w1[2 * q] * c0 + w2[2 * q] * n0);
                o[2 * q + 1] = gb1 * (w0[2 * q + 1] * p1 + w1[2 * q + 1] * c1 + w2[2 * q + 1] * n1); }
            u32x4 w; w.x = cvt_pk_bf16(o[0], o[1]); w.y = cvt_pk_bf16(o[2], o[3]); w.z = cvt_pk_bf16(o[4], o[5]); w.w = cvt_pk_bf16(o[6], o[7]);
            *(u32x4*)(Z + (size_t)(t0 + i) * DM + cg8) = w;
        }
    }
}
__device__ __forceinline__ void gla_out_phase(const bf16_t* Of, const bf16_t* Ob, const bf16_t* R, const float* ng, bf16_t* G, int ntok) {
    const int tid = opaque_tid(), wave = tid >> 6, lane = tid & 63;
    const int gw = blockIdx.x * 8 + wave, NGW = gridDim.x * 8;
    const float* ngp = ng + ((16 * lane) & 255);
    float ngv[16];
#pragma unroll
    for (int e = 0; e < 16; ++e) ngv[e] = ngp[e];
    for (int t0 = gw * 2; t0 < ntok; t0 += NGW * 2) {
        u32x4 av[2][2], bv[2][2], rv[2][2];
#pragma unroll
        for (int i = 0; i < 2; ++i) { const size_t off = (size_t)(t0 + i) * DM + 16 * lane;
            av[i][0] = __builtin_nontemporal_load((const u32x4*)(Of + off)); av[i][1] = __builtin_nontemporal_load((const u32x4*)(Of + off + 8)); bv[i][0] = __builtin_nontemporal_load((const u32x4*)(Ob + off)); bv[i][1] = __builtin_nontemporal_load((const u32x4*)(Ob + off + 8));
            rv[i][0] = __builtin_nontemporal_load((const u32x4*)(R + off)); rv[i][1] = __builtin_nontemporal_load((const u32x4*)(R + off + 8)); }
#pragma unroll
        for (int i = 0; i < 2; ++i) {
            float o[16]; float s = 0.f;
#pragma unroll
            for (int hh = 0; hh < 2; ++hh)
#pragma unroll
                for (int q = 0; q < 4; ++q) {
                    o[8 * hh + 2 * q] = bf2f((unsigned short)(av[i][hh][q] & 0xffff)) + bf2f((unsigned short)(bv[i][hh][q] & 0xffff));
                    o[8 * hh + 2 * q + 1] = bf2f((unsigned short)(av[i][hh][q] >> 16)) + bf2f((unsigned short)(bv[i][hh][q] >> 16)); }
#pragma unroll
            for (int e = 0; e < 16; ++e) s += o[e] * o[e];
            s += __shfl_xor(s, 1); s += __shfl_xor(s, 2); s += __shfl_xor(s, 4); s += __shfl_xor(s, 8);
            const float rstd = rsqrtf(s * (1.0f / 256.0f) + 1e-6f);
            float y[16];
#pragma unroll
            for (int hh = 0; hh < 2; ++hh)
#pragma unroll
                for (int q = 0; q < 4; ++q) {
                    y[8 * hh + 2 * q] = o[8 * hh + 2 * q] * rstd * ngv[8 * hh + 2 * q] * bf2f((unsigned short)(rv[i][hh][q] & 0xffff));
                    y[8 * hh + 2 * q + 1] = o[8 * hh + 2 * q + 1] * rstd * ngv[8 * hh + 2 * q + 1] * bf2f((unsigned short)(rv[i][hh][q] >> 16)); }
            u32x4 w0, w1;
            w0.x = cvt_pk_bf16(y[0], y[1]); w0.y = cvt_pk_bf16(y[2], y[3]); w0.z = cvt_pk_bf16(y[4], y[5]); w0.w = cvt_pk_bf16(y[6], y[7]);
            w1.x = cvt_pk_bf16(y[8], y[9]); w1.y = cvt_pk_bf16(y[10], y[11]); w1.z = cvt_pk_bf16(y[12], y[13]); w1.w = cvt_pk_bf16(y[14], y[15]);
            const size_t off = (size_t)(t0 + i) * DM + 16 * lane;
            *(u32x4*)(G + off) = w0; *(u32x4*)(G + off + 8) = w1;
        }
    }
}

constexpr int SC_QD = 0, SC_KI = 17408, SC_KDT = 34816, SC_VT = 53248, SC_ST = 71680, SC_P = 106496, SC_TOT = 115712, SC_DEC = 117760, SC_LA = 118272  ;
constexpr int PQ = 136, PS = 72;
__device__ __forceinline__ void gla_scan_phase(LAS unsigned char* lds, const bf16_t* QDf, const bf16_t* KIf, const bf16_t* QDb, const bf16_t* KIb, const float* ET, const bf16_t* VT, bf16_t* Of, bf16_t* Ob) {
    const int tid = opaque_tid(), w = __builtin_amdgcn_readfirstlane(tid >> 6), lane = tid & 63, fr = lane & 15, fq = lane >> 4;
    LAS bf16_t* QD = (LAS bf16_t*)(lds + SC_QD); LAS bf16_t* KI = (LAS bf16_t*)(lds + SC_KI); LAS bf16_t* KDT = (LAS bf16_t*)(lds + SC_KDT);
    LAS bf16_t* VTs = (LAS bf16_t*)(lds + SC_VT); LAS bf16_t* ST = (LAS bf16_t*)(lds + SC_ST); LAS bf16_t* Pm = (LAS bf16_t*)(lds + SC_P);
    LAS float* TOT = (LAS float*)(lds + SC_TOT); LAS float* DEC = (LAS float*)(lds + SC_DEC);
    const int d = tid & 127, seg = tid >> 7;
    for (int item = blockIdx.x; item < 256; item += gridDim.x) {
        const int es = item & 1, dir = (item >> 1) & 1, h = (item >> 2) & 3, b = item >> 4;
        bf16_t* Od = dir ? Ob : Of;
        for (int i = tid; i < 128 * PQ / 2; i += 512) ((LAS unsigned*)ST)[i] = 0u;
        f32x4 S[8];
#pragma unroll
        for (int dt = 0; dt < 8; ++dt) S[dt] = (f32x4){0.f, 0.f, 0.f, 0.f};
        __syncthreads();
        const bf16_t* QDg = dir ? QDb : QDf; const bf16_t* KIg = dir ? KIb : KIf;
        u32x4 qv[2][2], kv[2][2], vtv[2][2]; f32x4 etv[2][2][2]; float decv[2] = {0.f, 0.f};
        const int krow = tid & 63, kc8 = (tid >> 6) * 8;
#define SCAN_TOK0(st) ((st) < 4 ? (TL + b * 256 + (dir ? 3 - (st) : (st)) * 64) : (b * 2048 + (dir ? 31 - ((st) - 4) : ((st) - 4)) * 64))
#define SCAN_LOAD(st, S) do { const int _t0 = SCAN_TOK0(st); const float* _et = ET + ((size_t)(_t0 >> 6) * 2 + dir) * 512 + h * 128; \
            _Pragma("unroll") for (int i = 0; i < 2; ++i) { const int piece = tid + 512 * i; const int row = piece >> 4, c8 = (piece & 15) * 8; \
                qv[S][i] = *(const u32x4*)(QDg + (size_t)(_t0 + row) * 512 + h * 128 + c8); \
                kv[S][i] = *(const u32x4*)(KIg + (size_t)(_t0 + krow) * 512 + h * 128 + kc8 + 64 * i); \
                etv[S][i][0] = *(const f32x4*)(_et + kc8 + 64 * i); etv[S][i][1] = *(const f32x4*)(_et + kc8 + 64 * i + 4); \
                const int er = piece >> 3, pc = piece & 7; vtv[S][i] = *(const u32x4*)(VT + (size_t)(h * 256 + es * 128 + er) * TT + _t0 + 8 * pc); } \
            if (tid < 128) decv[S] = _et[tid]; } while (0)
        SCAN_LOAD(0, 0); SCAN_LOAD(1, 1);
        for (int step2 = 0; step2 < 36; step2 += 2) {
#pragma unroll
          for (int ss = 0; ss < 2; ++ss) {
            const int step = step2 + ss;
            const int tok0 = SCAN_TOK0(step);
#pragma unroll
            for (int i = 0; i < 2; ++i) { const int piece = tid + 512 * i; const int row = piece >> 4, c8 = (piece & 15) * 8;
                *(LAS u32x4*)(QD + row * PQ + c8) = qv[ss][i];
                *(LAS u32x4*)(KI + krow * PQ + kc8 + 64 * i) = kv[ss][i];
                const f32x4 e0 = etv[ss][i][0], e1 = etv[ss][i][1];
#pragma unroll
                for (int q = 0; q < 4; ++q) { const float klo = bf2f((unsigned short)(kv[ss][i][q] & 0xffff)), khi = bf2f((unsigned short)(kv[ss][i][q] >> 16));
                    const float elo = (2 * q < 4) ? e0[(2 * q) & 3] : e1[(2 * q) & 3], ehi = (2 * q + 1 < 4) ? e0[(2 * q + 1) & 3] : e1[(2 * q + 1) & 3];
                    KDT[(kc8 + 64 * i + 2 * q) * PS + krow] = f2bf(klo * elo); KDT[(kc8 + 64 * i + 2 * q + 1) * PS + krow] = f2bf(khi * ehi); }
                const int er = piece >> 3, pc = piece & 7; *(LAS u32x4*)(VTs + er * PS + 8 * pc) = vtv[ss][i]; }
            if (tid < 128) DEC[tid] = decv[ss];
            __syncthreads();
            if (step + 2 < 36) SCAN_LOAD(step + 2, ss);
#define FRAG(base, row, pitch, ks) (*(const LAS bf16x8*)((base) + (row) * (pitch) + (ks) * 32 + fq * 8))
            {
                const int id0 = 2 * w, ct0 = id0 >> 2, st0 = id0 & 3, st1 = st0 + 1;
                bf16x8 qa[4], kb0[4], kb1[4];
#pragma unroll
                for (int ks = 0; ks < 4; ++ks) { qa[ks] = FRAG(QD, ct0 * 16 + fr, PQ, ks); kb0[ks] = FRAG(KI, st0 * 16 + fr, PQ, ks); kb1[ks] = FRAG(KI, st1 * 16 + fr, PQ, ks); }
                bf16x8 sa[4];
#pragma unroll
                for (int ks = 0; ks < 4; ++ks) sa[ks] = FRAG(ST, 16 * w + fr, PQ, ks);
#pragma unroll
                for (int dt = 0; dt < 8; ++dt) { const f32x4 dcv = *(const LAS f32x4*)(DEC + 16 * dt + 4 * fq); S[dt] = S[dt] * dcv; }
                __builtin_amdgcn_sched_barrier(0);
                f32x4 a0 = (f32x4){0.f, 0.f, 0.f, 0.f}, a1 = a0;
#pragma unroll
                for (int ks = 0; ks < 4; ++ks) { a0 = __builtin_amdgcn_mfma_f32_16x16x32_bf16(qa[ks], kb0[ks], a0, 0, 0, 0); a1 = __builtin_amdgcn_mfma_f32_16x16x32_bf16(qa[ks], kb1[ks], a1, 0, 0, 0); }
#pragma unroll
                for (int rg = 0; rg < 4; ++rg) { const int c_ = ct0 * 16 + 4 * fq + rg; const int s0_ = st0 * 16 + fr, s1_ = st1 * 16 + fr;
                    const bool k0_ = dir == 0 ? (s0_ <= c_) : (s0_ >= c_), k1_ = dir == 0 ? (s1_ <= c_) : (s1_ >= c_);
                    Pm[c_ * PS + s0_] = k0_ ? f2bf(a0[rg]) : (bf16_t)0; Pm[c_ * PS + s1_] = k1_ ? f2bf(a1[rg]) : (bf16_t)0; }
                f32x4 oacc[4];
#pragma unroll
                for (int ct = 0; ct < 4; ++ct) oacc[ct] = (f32x4){0.f, 0.f, 0.f, 0.f};
#pragma unroll
                for (int ct = 0; ct < 4; ++ct) {
                    bf16x8 qb[4];
#pragma unroll
                    for (int ks = 0; ks < 4; ++ks) qb[ks] = FRAG(QD, 16 * ct + fr, PQ, ks);
#pragma unroll
                    for (int ks = 0; ks < 4; ++ks) oacc[ct] = __builtin_amdgcn_mfma_f32_16x16x32_bf16(sa[ks], qb[ks], oacc[ct], 0, 0, 0);
                }
                __syncthreads();
                bf16x8 va[2], pb[4][2];
#pragma unroll
                for (int ks = 0; ks < 2; ++ks) { va[ks] = FRAG(VTs, 16 * w + fr, PS, ks);
#pragma unroll
                    for (int ct = 0; ct < 4; ++ct) pb[ct][ks] = FRAG(Pm, 16 * ct + fr, PS, ks); }
                __builtin_amdgcn_sched_barrier(0);
#pragma unroll
                for (int ks = 0; ks < 2; ++ks)
#pragma unroll
                    for (int ct = 0; ct < 4; ++ct) oacc[ct] = __builtin_amdgcn_mfma_f32_16x16x32_bf16(va[ks], pb[ct][ks], oacc[ct], 0, 0, 0);
#pragma unroll
                for (int ct = 0; ct < 4; ++ct) { u32x2 wv; wv.x = cvt_pk_bf16(oacc[ct][0], oacc[ct][1]); wv.y = cvt_pk_bf16(oacc[ct][2], oacc[ct][3]);
                    *(u32x2*)(Od + (size_t)(tok0 + 16 * ct + fr) * DM + h * 256 + es * 128 + 16 * w + 4 * fq) = wv; }
#pragma unroll
                for (int half = 0; half < 2; ++half) {
                    bf16x8 ka[4][2];
#pragma unroll
                    for (int dd = 0; dd < 4; ++dd)
#pragma unroll
                        for (int ks = 0; ks < 2; ++ks) ka[dd][ks] = FRAG(KDT, 16 * (4 * half + dd) + fr, PS, ks);
                    __builtin_amdgcn_sched_barrier(0);
#pragma unroll
                    for (int ks = 0; ks < 2; ++ks)
#pragma unroll
                        for (int dd = 0; dd < 4; ++dd) S[4 * half + dd] = __builtin_amdgcn_mfma_f32_16x16x32_bf16(ka[dd][ks], va[ks], S[4 * half + dd], 0, 0, 0);
                }
#pragma unroll
                for (int dt = 0; dt < 8; ++dt) { u32x2 wv; wv.x = cvt_pk_bf16(S[dt][0], S[dt][1]); wv.y = cvt_pk_bf16(S[dt][2], S[dt][3]); *(LAS u32x2*)(ST + (16 * w + fr) * PQ + 16 * dt + 4 * fq) = wv; }
            }
#undef FRAG
            __syncthreads();
          }
        }
    }
}

#undef SCAN_LOAD
#undef SCAN_TOK0
__global__ void __launch_bounds__(512, 2) fwd_megakernel(Params P) {
    extern __shared__ __attribute__((aligned(16))) unsigned char lds_raw[];
    LAS unsigned char* lds = (LAS unsigned char*)lds_raw;
    cg::grid_group grid = cg::this_grid();
#define GSYNC0() do { asm volatile("s_waitcnt vmcnt(0) lgkmcnt(0)" ::: "memory"); __syncthreads(); grid.sync(); asm volatile("s_waitcnt vmcnt(0) lgkmcnt(0)" ::: "memory"); __syncthreads(); } while (0)
    volatile LAS unsigned* xb_st = (volatile LAS unsigned*)(lds + LDS_BYTES - 16);
    if (threadIdx.x == 0) { xb_st[0] = 0u; xb_st[1] = 0u; }
    __syncthreads();
    const XcdBarrier xbar = xcd_barrier_post((unsigned*)(P.ws + WS_CTL), xb_st);
#define GSYNC() xcd_barrier(xbar)
    const int G = gridDim.x, bx = blockIdx.x;
    unsigned char* ws = P.ws;
    float* mod = (float*)(ws + WS_MOD);
    float* Xl = P.out; float* Xc = (float*)(ws + WS_XCTX);
    bf16_t* HZ = (bf16_t*)(ws + WS_HZ); bf16_t* BIG = (bf16_t*)(ws + WS_BIG);
    bf16_t* QDf = (bf16_t*)(ws + WS_BIG); bf16_t* KIf = (bf16_t*)(ws + WS_BIG + 36 * MiB); bf16_t* QDb = (bf16_t*)(ws + WS_BIG + 72 * MiB); bf16_t* KIb = (bf16_t*)(ws + WS_BIG + 108 * MiB); bf16_t* VTb = (bf16_t*)(ws + WS_BIG + BIG_VT);
    float* ETb = (float*)(ws + WS_ET);
    bf16_t* Rb = (bf16_t*)(ws + WS_R); bf16_t* Obb = (bf16_t*)(ws + WS_OB);
    bf16_t* Dpb = (bf16_t*)(ws + WS_OB);
    bf16_t* Db = (bf16_t*)(ws + WS_R);

#ifndef NO_ADA
    ada_phase(lds, P);
#endif
    GSYNC0();
#pragma unroll 1
    for (int layer = 0; layer < 4; ++layer) {
        const int kind = layer & 1, j = layer >> 1; const bool last = layer == 3;
        const float* modl = mod + (size_t)layer * NCOND * NADA;
        const float* src_lat = layer == 0 ? P.in[I_X] : Xl; const float* src_ctx = layer == 0 ? P.in[I_CTX] : Xc;
        const int Mall = TT, Mres = last ? TL : TT;
        unsigned char* wb = ws + ((layer & 1) ? WS_W2 : 0);
        bf16_t* Win_t = (bf16_t*)(wb + WS_WIN); bf16_t* Wout_t = (bf16_t*)(wb + WS_WOUT); bf16_t* Wf1_t = (bf16_t*)(wb + WS_WF1); bf16_t* Wf2_t = (bf16_t*)(wb + WS_WF2);
#ifndef NO_PREP
        prep_layer(lds, P, layer, 0, G);
#endif
        norm_mod_phase(src_lat, src_ctx, layer == 0 ? (const bf16_t*)nullptr : Db, Dpb, layer == 0 ? (float*)nullptr : Xl, Xc, P.in[I_N1G] + layer * DM, modl, 0, 1024, HZ, Mall);
        GSYNC();
        if (kind == 1) {
            pg8::Gemm g{HZ, Win_t, Mall, 3072, 1024}; pg8::StaticOrder S; S.init(Mall, 3072, 1024, G, bx);
            EpiGla E{QDf, KIf, QDb, KIb, Rb, ETb, P.in[I_GBR] + j * 1024, P.in[I_GBA] + j * 1024};
#ifndef NO_GGLA
            pg8::gemm_phase<EpiGla>(lds, g, S, E);
#endif
        }
        if (kind == 0) {
            pg8::Gemm g{HZ, Win_t, Mall, 3072, 1024}; pg8::StaticOrder S; S.init(Mall, 3072, 1024, G, bx);
            EpiConvIn E{BIG};
#ifndef NO_GPLAIN
            pg8::gemm_phase<EpiConvIn>(lds, g, S, E);
#endif
        } else {
            pg8::Gemm g{Win_t + (size_t)3072 * 1024, HZ, 1024, Mall, 1024}; pg8::StaticOrder S; S.init(1024, Mall, 1024, G, (bx + 64) % G);
            EpiPlain E{VTb, (size_t)TT};
#ifndef NO_GPLAIN
            pg8::gemm_phase<EpiPlain>(lds, g, S, E);
#endif
        }
        GSYNC();
        const bf16_t* Aout;
        if (kind == 0) {
            conv_phase(BIG, P.in[I_CW] + j * 3 * 1024, HZ, Mres);
            Aout = HZ;
        } else {
#ifndef NO_SCAN
            gla_scan_phase(lds, QDf, KIf, QDb, KIb, ETb, VTb, HZ, Obb);
#endif
            GSYNC();
            gla_out_phase(HZ, Obb, Rb, P.in[I_GNG] + j * 256, BIG, Mres);
            Aout = BIG;
        }
        GSYNC();
        {
            pg8::Gemm g{Aout, Wout_t, Mres, 1024, 1024};
            EpiDelta E{Db, modl + 2048, Dpb, last ? 0 : 1};
#ifndef NO_GRES
            if (last) { pg8::StaticOrder S; S.init(Mres, 1024, 1024, G, bx); pg8::gemm_phase<EpiDelta>(lds, g, S, E); }
            else { pg8::TailOrder S; S.init(1024, 1024, G, bx); pg8::gemm_phase<EpiDelta, pg8::TailOrder>(lds, g, S, E); }
#endif
        }
        GSYNC();
        norm_mod_phase(src_lat, src_ctx, Db, last ? (const bf16_t*)nullptr : Dpb, Xl, Xc, P.in[I_N2G] + layer * DM, modl, 3072, 4096, HZ, Mres);
        GSYNC();
        {
            pg8::Gemm g{HZ, Wf1_t, Mres, 5632, 1024}; pg8::StaticOrder S; S.init(Mres, 5632, 1024, G, bx);
            EpiSwiglu E{BIG};
#ifndef NO_GSWI
            pg8::gemm_phase<EpiSwiglu>(lds, g, S, E);
#endif
        }
        GSYNC();
        {
            pg8::Gemm g{BIG, Wf2_t, Mres, 1024, 2816};
            EpiDelta E{Db, modl + 5120, Dpb, last ? 0 : 1};
#ifndef NO_GRES
            if (last) { pg8::StaticOrder S; S.init(Mres, 1024, 2816, G, bx); pg8::gemm_phase<EpiDelta>(lds, g, S, E); }
            else { pg8::TailOrder S; S.init(1024, 2816, G, bx); pg8::gemm_phase<EpiDelta, pg8::TailOrder>(lds, g, S, E); }
#endif
        }
        GSYNC();
    }
    final_norm_phase(Xl, Db, P.in[I_FG], P.out);
}

extern "C" void kernel_launch(void* const* d_in, const int* in_sizes, int n_in, void* d_out, int out_size, void* d_ws, size_t ws_size, hipStream_t stream) {
    static int grid_blocks = 0;
    if (grid_blocks == 0) {
        if (n_in != 21 || ws_size < WS_END) { fprintf(stderr, "kernel_launch: unexpected n_in %d / ws_size %zu (need %zu)\n", n_in, ws_size, (size_t)WS_END); grid_blocks = -1; return; }
        int dev = 0, cus = 0, per_cu = 0;
        hipGetDevice(&dev);
        hipDeviceGetAttribute(&cus, hipDeviceAttributeMultiprocessorCount, dev);
        if (hipFuncSetAttribute((const void*)fwd_megakernel, hipFuncAttributeMaxDynamicSharedMemorySize, LDS_BYTES) != hipSuccess) { fprintf(stderr, "kernel_launch: hipFuncSetAttribute failed\n"); grid_blocks = -1; return; }
        if (hipOccupancyMaxActiveBlocksPerMultiprocessor(&per_cu, (const void*)fwd_megakernel, 512, LDS_BYTES) != hipSuccess || per_cu < 1) { fprintf(stderr, "kernel_launch: occupancy query says %d\n", per_cu); per_cu = 1; }
        (void)hipGetLastError();
        grid_blocks = cus;
    }
    if (grid_blocks < 0) return;
    if (hipMemsetAsync((char*)d_ws + WS_CTL, 0, XCD_BAR_WORDS * 4, stream) != hipSuccess) { fprintf(stderr, "kernel_launch: memset of the barrier words failed\n"); return; }
    Params p{};
    for (int i = 0; i < 21; ++i) p.in[i] = (const float*)d_in[i];
    p.out = (float*)d_out; p.ws = (unsigned char*)d_ws;
    void* args[] = {&p};
    hipError_t e = hipLaunchCooperativeKernel((const void*)fwd_megakernel, dim3(grid_blocks), dim3(512), args, LDS_BYTES, stream);
    if (e != hipSuccess) fprintf(stderr, "cooperative launch failed: %s (grid %d)\n", hipGetErrorString(e), grid_blocks);
}
```

```cpp
#include <hip/hip_runtime.h>
#include <hip/hip_cooperative_groups.h>
#include <cstdio>
#include <cstdint>
namespace cg = cooperative_groups;

#define LAS __attribute__((address_space(3)))
typedef unsigned short bf16_t;
typedef short bf16x8 __attribute__((ext_vector_type(8)));
typedef float f32x4 __attribute__((ext_vector_type(4)));
typedef float f32x2 __attribute__((ext_vector_type(2)));
typedef unsigned u32x4 __attribute__((ext_vector_type(4)));
typedef unsigned u32x2 __attribute__((ext_vector_type(2)));

constexpr int DM = 1024, TL = 32768, TC = 4096, TT = TL + TC, DFF = 2816, NCOND = 17, NADA = 6144;
constexpr int LDS_BYTES = 147456;
constexpr size_t MiB = 1u << 20;
constexpr size_t WS_WIN = 0, WS_WOUT = 8 * MiB, WS_WF1 = 10 * MiB, WS_WF2 = 21 * MiB, WS_MOD = 27 * MiB, WS_XCTX = 29 * MiB,
                 WS_HZ = 45 * MiB, WS_BIG = 117 * MiB, WS_R = 333 * MiB, WS_OB = 405 * MiB, WS_W2 = 477 * MiB  , WS_CTL = 504 * MiB, WS_ET = 505 * MiB  , WS_END = 508 * MiB;
constexpr size_t BIG_Q = 0, BIG_K = 36 * MiB, BIG_LA = 72 * MiB, BIG_VT = 144 * MiB;

struct Params { const float* in[21]; float* out; unsigned char* ws; };
enum { I_X = 0, I_C, I_CTX, I_CCTX, I_ADAW, I_ADAB, I_N1G, I_N2G, I_CWIN, I_CW, I_CWOUT, I_GWIN, I_GBR, I_GA1, I_GA2, I_GBA, I_GNG, I_GWOUT, I_FWIN, I_FWOUT, I_FG };

typedef __bf16 bf16x2v __attribute__((ext_vector_type(2)));
__device__ __forceinline__ unsigned cvt_pk_bf16(float lo, float hi) { f32x2 v = {lo, hi}; bf16x2v b = __builtin_convertvector(v, bf16x2v); return __builtin_bit_cast(unsigned, b); }
__device__ __forceinline__ float bf2f(unsigned short b) { return __uint_as_float(((unsigned)b) << 16); }
__device__ __forceinline__ unsigned short f2bf(float f) { return (unsigned short)(cvt_pk_bf16(f, 0.f) & 0xffffu); }
__device__ __forceinline__ float silu_f(float v) { return v * __builtin_amdgcn_rcpf(1.0f + __expf(-v)); }
__device__ __forceinline__ float wave_sum(float v) {
#pragma unroll
    for (int o = 1; o < 64; o <<= 1) v += __shfl_xor(v, o);
    return v;
}
__device__ __forceinline__ int opaque_tid() { int t = threadIdx.x; asm volatile("" : "+v"(t)); return t; }

__device__ __forceinline__ void grid_bar(unsigned* ctr, unsigned target) {
    asm volatile("s_waitcnt vmcnt(0) lgkmcnt(0)" ::: "memory");
    __syncthreads();
    if (threadIdx.x == 0) {
        __builtin_amdgcn_fence(__ATOMIC_RELEASE, "agent");
        asm volatile("s_waitcnt vmcnt(0)" ::: "memory");
        __hip_atomic_fetch_add(ctr, 1u, __ATOMIC_RELAXED, __HIP_MEMORY_SCOPE_AGENT);
        __builtin_amdgcn_fence(__ATOMIC_ACQUIRE, "agent");
        unsigned polls = 0; const unsigned long long t0 = __builtin_amdgcn_s_memrealtime();
        while ((int)(__hip_atomic_load(ctr, __ATOMIC_RELAXED, __HIP_MEMORY_SCOPE_AGENT) - target) < 0) {
            __builtin_amdgcn_s_sleep(1);
            if ((++polls & 255u) == 0u && __builtin_amdgcn_s_memrealtime() - t0 > 200000000ull) break;
        }
        asm volatile("s_waitcnt vmcnt(0)" ::: "memory");
    }
    __syncthreads();
}

#define XB_TMO      128
#define XB_XCNT(j)  (256  + 64 * (j))
#define XB_XSUB(j)  (1280 + 64 * (j))
#define XB_XGEN(j)  (2304 + 64 * (j))
#define XB_TOP      3328
#define XB_TOPGEN   3392
#define XCD_BAR_WORDS 3456
#define XB_SPIN_CAP (1u << 18)
__device__ __forceinline__ unsigned xb_ld(unsigned* p)              { return __hip_atomic_load(p, __ATOMIC_RELAXED, __HIP_MEMORY_SCOPE_AGENT); }
__device__ __forceinline__ unsigned xb_add(unsigned* p, unsigned v) { return __hip_atomic_fetch_add(p, v, __ATOMIC_RELAXED, __HIP_MEMORY_SCOPE_AGENT); }
__device__ __forceinline__ unsigned xb_xcc_id() { return (unsigned)__builtin_amdgcn_s_getreg((3 << 11) | 20) & 0xFu; }
#define XB_SPIN(cond, bar) do { unsigned _sp = 0; while (cond) { __builtin_amdgcn_s_sleep(1); \
    if ((++_sp & 255u) == 0u) { if (xb_ld(&(bar)[XB_TMO])) break; if (_sp > XB_SPIN_CAP) { atomicAdd(&(bar)[XB_TMO], 1u); break; } } } } while (0)
struct XcdBarrier { unsigned* bar; unsigned x; volatile LAS unsigned* st; };
__device__ __forceinline__ XcdBarrier xcd_barrier_post(unsigned* bar, volatile LAS unsigned* st) {
    XcdBarrier b; b.bar = bar; b.x = xb_xcc_id(); b.st = st;
    if (threadIdx.x == 0) (void)xb_add(&bar[XB_XCNT(b.x)], 1u);
    return b;
}
__device__ __forceinline__ void xcd_barrier_complete(unsigned* bar, unsigned x, unsigned& nloc, unsigned& nx) {
    const unsigned G = gridDim.x * gridDim.y * gridDim.z;
    unsigned sum, cnt, mine, sp = 0u;
    for (;;) {
        sum = 0u; cnt = 0u; mine = 0u;
#pragma unroll
        for (unsigned j = 0; j < 16; ++j) { const unsigned c = xb_ld(&bar[XB_XCNT(j)]); sum += c; cnt += (c > 0u) ? 1u : 0u; mine = (j == x) ? c : mine; }
        if (sum == G) break;
        __builtin_amdgcn_s_sleep(1);
        if ((++sp & 255u) == 0u) { if (xb_ld(&bar[XB_TMO])) break; if (sp > XB_SPIN_CAP) { atomicAdd(&bar[XB_TMO], 1u); break; } }
    }
    nloc = mine > 0u ? mine : 1u; nx = cnt > 0u ? cnt : 1u;
}
__device__ __forceinline__ void xcd_barrier(const XcdBarrier& b) {
    asm volatile("s_waitcnt vmcnt(0) lgkmcnt(0)" ::: "memory");
    __syncthreads();
    if (threadIdx.x == 0) {
        unsigned* bar = b.bar;
        __builtin_amdgcn_s_waitcnt(0);
        unsigned nloc = b.st[0], nx = b.st[1];
        if (nloc == 0u) { xcd_barrier_complete(bar, b.x, nloc, nx); b.st[0] = nloc; b.st[1] = nx; }
        const unsigned old = xb_add(&bar[XB_XSUB(b.x)], 1u);
        const unsigned gen = old / nloc;
        if (old + 1u == (gen + 1u) * nloc) {
            __builtin_amdgcn_fence(__ATOMIC_RELEASE, "agent");
            asm volatile("s_waitcnt vmcnt(0)" ::: "memory");
            const unsigned og = xb_add(&bar[XB_TOP], 1u);
            const unsigned tg = og / nx;
            __builtin_amdgcn_fence(__ATOMIC_ACQUIRE, "agent");
            if (og + 1u == (tg + 1u) * nx) xb_add(&bar[XB_TOPGEN], 1u);
            else XB_SPIN(xb_ld(&bar[XB_TOPGEN]) == tg, bar);
            xb_add(&bar[XB_XGEN(b.x)], 1u);
            asm volatile("s_waitcnt vmcnt(0)" ::: "memory");
        } else {
            __builtin_amdgcn_fence(__ATOMIC_ACQUIRE, "agent");
            XB_SPIN(xb_ld(&bar[XB_XGEN(b.x)]) == gen, bar);
            asm volatile("s_waitcnt vmcnt(0)" ::: "memory");
        }
    }
    __syncthreads();
}
#define LDS_WAIT() asm volatile("s_waitcnt lgkmcnt(0)" ::: "memory")

namespace pg8 {
constexpr int BM = 256, BK = 64, HALF = 128, HTB = HALF * BK * 2, STAGE_BYTES = 8 * HTB, NXCD = 8, WGM = 8;
__host__ __device__ __forceinline__ int lds_byte(int r, int c) { const int st = (r >> 4) * 2 + (c >> 5), rr = r & 15, cc = c & 31, ob = rr * 64 + cc * 2; return st * 1024 + (ob ^ (((ob >> 9) & 1) << 5)); }
__host__ __device__ __forceinline__ void stage_rc(int b, int& R, int& C) { const int st = b / 1024, sb = b % 1024, swz = sb ^ (((sb >> 9) & 1) << 5); R = (st >> 1) * 16 + swz / 64; C = (st & 1) * 32 + (swz % 64) / 2; }

__host__ __device__ __forceinline__ int perm32(int rho) { const int n = rho >> 4, i = rho & 15; return 8 * (i >> 2) + 4 * n + (i & 3); }
struct Unit { int pm, pn, k0, nt, part; };
struct Gemm { const bf16_t* A; const bf16_t* Bt; int M, N, K; };

struct StaticOrder {
    int nM, nN, nwg, G, c, ktiles;
    __host__ __device__ void init(int M, int N, int K, int G_, int c_) { nM = M / BM; nN = N / BM; nwg = nM * nN; G = G_; c = c_; ktiles = K / BK; }
    __host__ __device__ __forceinline__ int map(int L) const {
        int wgid = L; { const int q = nwg / NXCD, r = nwg % NXCD, xcd = wgid % NXCD, off = wgid / NXCD; wgid = (xcd < r ? xcd * (q + 1) : r * (q + 1) + (xcd - r) * q) + off; }
        const int nig = WGM * nN, gid = wgid / nig, fm = gid * WGM, gsz = (nM - fm) < WGM ? (nM - fm) : WGM;
        return ((fm + ((wgid % nig) % gsz)) << 16) | ((wgid % nig) / gsz);
    }
    __host__ __device__ __forceinline__ bool next(int i, Unit& u) const {
        const long L = (long)i * G + c; if (L >= nwg) return false;
        const int pp = map((int)L); Unit t; t.pm = pp >> 16; t.pn = pp & 0xffff; t.k0 = 0; t.nt = ktiles; t.part = 0; u = t; return true;
    }
};
struct TailOrder {
    StaticOrder lat; int q, r;
    __host__ __device__ void init(int N, int K, int G_, int c_) { lat.init(TL, N, K, G_, c_); const int kt = K / BK; q = (kt / 4) & ~1; r = kt - 4 * q; }
    __host__ __device__ __forceinline__ bool next(int i, Unit& u) const {
        const long L = (long)i * lat.G + lat.c;
        const int s = (int)(L - lat.nwg); if (s >= 64 * 4) return false;
        const bool whole = L < lat.nwg;
        const int pp = lat.map(whole ? (int)L : 0);
        const int part = s & 3, h2 = r >> 1;
        Unit t;
        t.pm = whole ? (pp >> 16) : TL / BM + (s >> 4); t.pn = whole ? (pp & 0xffff) : ((s >> 2) & 3);
        t.k0 = whole ? 0 : part * q + 2 * (part < h2 ? part : h2); t.nt = whole ? lat.ktiles : q + (part < h2 ? 2 : 0); t.part = whole ? 0 : part;
        u = t; return true;
    }
};

template <class Epi, class Sched = StaticOrder, bool ALIGN_EPI = true>
__device__ __forceinline__ void gemm_phase(LAS unsigned char* lds, const Gemm g, const Sched& S, const Epi& E) {
    const int tid = opaque_tid(), wid = __builtin_amdgcn_readfirstlane(tid >> 6), lane = tid & 63, wr = wid >> 2, wc = wid & 3, fr = lane & 15, fq = lane >> 4;
    const int K = g.K;
    unsigned voffA[2], voffB[2];
#pragma unroll
    for (int i = 0; i < 2; ++i) { int R, C; stage_rc(tid * 16 + i * 8192, R, C); const int Rb = (R & ~31) + perm32(R & 31); voffA[i] = (unsigned)(R * K + C) * 2u; voffB[i] = (unsigned)(Rb * K + C) * 2u; }
    const size_t kstep = (size_t)(BK * 2);
    const size_t hstep = (size_t)HALF * K * 2;
    const size_t tstep = 2 * hstep;
    const unsigned ldsw = (unsigned)wid * 1024u;
    const int aoff = lds_byte(wr * 64 + fr, fq * 8), boff = lds_byte(wc * 32 + fr, fq * 8);
#define PG8_SA(b, h) (((b) * 2 + (h)) * HTB)
#define PG8_SB(b, h) ((4 + (b) * 2 + (h)) * HTB)
#define PG8_STAGE(bufoff, gbase, voff) do { _Pragma("unroll") for (int _i = 0; _i < 2; ++_i) \
        __builtin_amdgcn_global_load_lds((const unsigned*)((const char*)(gbase) + (voff)[_i]), (LAS unsigned*)(lds + (bufoff) + ldsw + _i * 8192), 16, 0, 0); } while (0)
#define PG8_LDA(dst, b, h) do { _Pragma("unroll") for (int m = 0; m < 4; ++m) _Pragma("unroll") for (int k = 0; k < 2; ++k) dst[m][k] = *(const LAS bf16x8*)(lds + PG8_SA(b, h) + aoff + m * 2048 + k * 1024); } while (0)
#define PG8_LDB(dst, b, h) do { _Pragma("unroll") for (int n = 0; n < 2; ++n) _Pragma("unroll") for (int k = 0; k < 2; ++k) dst[n][k] = *(const LAS bf16x8*)(lds + PG8_SB(b, h) + boff + n * 2048 + k * 1024); } while (0)
#define PG8_MMA(ai, bj, At, Bt) do { __builtin_amdgcn_s_setprio(1); _Pragma("unroll") for (int m = 0; m < 4; ++m) _Pragma("unroll") for (int n = 0; n < 2; ++n) _Pragma("unroll") for (int k = 0; k < 2; ++k) \
        acc[ai][bj][m][n] = __builtin_amdgcn_mfma_f32_16x16x32_bf16(Bt[n][k], At[m][k], acc[ai][bj][m][n], 0, 0, 0); __builtin_amdgcn_s_setprio(0); } while (0)
#define PG8_WAIT_V(n) asm volatile("s_waitcnt vmcnt(" #n ")" ::: "memory")
#define PG8_WAIT_L(n) asm volatile("s_waitcnt lgkmcnt(" #n ")" ::: "memory")
#define PG8_BAR __builtin_amdgcn_s_barrier()
#define PG8_SCHED __builtin_amdgcn_sched_barrier(0)
    Unit cur, nxt; int ui = 0;
    if (!S.next(0, cur)) return;
    f32x4 acc[2][2][4][2];
#pragma unroll
    for (int a = 0; a < 2; ++a)
#pragma unroll
        for (int b = 0; b < 2; ++b)
#pragma unroll
            for (int m = 0; m < 4; ++m)
#pragma unroll
                for (int n = 0; n < 2; ++n) acc[a][b][m][n] = (f32x4){0.f, 0.f, 0.f, 0.f};
    bf16x8 At[4][2], B0[2][2], B1[2][2];
    const char* cA = (const char*)g.A + (size_t)cur.pm * tstep + (size_t)cur.k0 * kstep; const char* cB = (const char*)g.Bt + (size_t)cur.pn * tstep + (size_t)cur.k0 * kstep;
    PG8_STAGE(PG8_SB(0, 0), cB, voffB); PG8_STAGE(PG8_SB(0, 1), cB + hstep, voffB); PG8_STAGE(PG8_SA(0, 0), cA, voffA); PG8_STAGE(PG8_SA(0, 1), cA + hstep, voffA);
    if (wr == 1) PG8_BAR;
    PG8_WAIT_V(2); PG8_BAR;
    PG8_STAGE(PG8_SB(1, 0), cB + kstep, voffB); PG8_STAGE(PG8_SA(1, 0), cA + kstep, voffA); PG8_STAGE(PG8_SB(1, 1), cB + hstep + kstep, voffB);
    PG8_WAIT_V(6); PG8_BAR;
    for (;;) {
        const bool has_next = S.next(ui + 1, nxt);
        const char* nA = has_next ? (const char*)g.A + (size_t)nxt.pm * tstep + (size_t)nxt.k0 * kstep : cA; const char* nB = has_next ? (const char*)g.Bt + (size_t)nxt.pn * tstep + (size_t)nxt.k0 * kstep : cB;
        const int nt = cur.nt;
        for (int t = 0; t < nt; t += 2) {
            const bool last = (t == nt - 2);
            const char* a1 = cA + (size_t)(t + 1) * kstep;
            const char* a2 = last ? nA : cA + (size_t)(t + 2) * kstep; const char* b2 = last ? nB : cB + (size_t)(t + 2) * kstep;
            const char* a3 = a2 + kstep; const char* b3 = b2 + kstep;
            PG8_LDB(B0, 0, 0); PG8_LDB(B1, 0, 1); PG8_SCHED; PG8_LDA(At, 0, 0); PG8_STAGE(PG8_SA(1, 1), a1 + hstep, voffA);
            PG8_WAIT_V(8); PG8_WAIT_L(0); PG8_BAR; PG8_MMA(0, 0, At, B0); PG8_MMA(0, 1, At, B1); PG8_BAR; PG8_SCHED;
            PG8_LDA(At, 0, 1); PG8_STAGE(PG8_SB(0, 0), b2, voffB); PG8_STAGE(PG8_SB(0, 1), b2 + hstep, voffB); PG8_STAGE(PG8_SA(0, 0), a2, voffA);
            PG8_WAIT_V(8); PG8_WAIT_L(0); PG8_BAR; PG8_MMA(1, 0, At, B0); PG8_MMA(1, 1, At, B1); PG8_BAR; PG8_SCHED;
            PG8_LDB(B0, 1, 0); PG8_LDB(B1, 1, 1); PG8_SCHED; PG8_LDA(At, 1, 0); PG8_STAGE(PG8_SA(0, 1), a2 + hstep, voffA);
            PG8_WAIT_V(8); PG8_WAIT_L(0); PG8_BAR; PG8_MMA(0, 0, At, B0); PG8_MMA(0, 1, At, B1); PG8_BAR; PG8_SCHED;
            PG8_LDA(At, 1, 1); PG8_STAGE(PG8_SB(1, 0), b3, voffB); PG8_STAGE(PG8_SB(1, 1), b3 + hstep, voffB); PG8_STAGE(PG8_SA(1, 0), a3, voffA);
            PG8_WAIT_V(8); PG8_WAIT_L(0); PG8_BAR; PG8_MMA(1, 0, At, B0); PG8_MMA(1, 1, At, B1); PG8_BAR; PG8_SCHED;
        }
        if constexpr (ALIGN_EPI) { if (wr == 0) PG8_BAR; }
        E(acc, cur, wr, wc, fr, fq);
        if (!has_next) break;
#pragma unroll
        for (int a = 0; a < 2; ++a)
#pragma unroll
            for (int b = 0; b < 2; ++b)
#pragma unroll
                for (int m = 0; m < 4; ++m)
#pragma unroll
                    for (int n = 0; n < 2; ++n) acc[a][b][m][n] = (f32x4){0.f, 0.f, 0.f, 0.f};
        cur = nxt; cA = nA; cB = nB; ++ui;
        if constexpr (ALIGN_EPI) { if (wr == 1) PG8_BAR; }
    }
    PG8_WAIT_V(0);
    if constexpr (!ALIGN_EPI) { if (wr == 0) PG8_BAR; }
    PG8_BAR;
#undef PG8_SA
#undef PG8_SB
#undef PG8_STAGE
#undef PG8_LDA
#undef PG8_LDB
#undef PG8_MMA
#undef PG8_WAIT_V
#undef PG8_WAIT_L
#undef PG8_BAR
#undef PG8_SCHED
}
}
using pg8::Unit;
typedef f32x4 AccT[2][2][4][2];

#define PACK8(v0, v1) (u32x4){cvt_pk_bf16((v0)[0], (v0)[1]), cvt_pk_bf16((v0)[2], (v0)[3]), cvt_pk_bf16((v1)[0], (v1)[1]), cvt_pk_bf16((v1)[2], (v1)[3])}
struct EpiPlain {
    bf16_t* O; size_t ldc;
    __device__ __forceinline__ void operator()(const AccT& acc, const Unit& u, int wr, int wc, int fr, int fq) const {
        const int row0 = u.pm * 256 + wr * 64 + fr, col0 = u.pn * 256 + wc * 32 + 8 * fq;
#pragma unroll
        for (int ai = 0; ai < 2; ++ai)
#pragma unroll
            for (int m = 0; m < 4; ++m) { bf16_t* rowp = O + (size_t)(row0 + ai * 128 + m * 16) * ldc + col0;
#pragma unroll
                for (int bj = 0; bj < 2; ++bj) *(u32x4*)(rowp + bj * 128) = PACK8(acc[ai][bj][m][0], acc[ai][bj][m][1]); }
    }
};
struct EpiGla {
    bf16_t *QDf, *KIf, *QDb, *KIb, *R; float* ET; const float *b_r, *b_a;
    __device__ __forceinline__ void operator()(const AccT& acc, const Unit& u, int wr, int wc, int fr, int fq) const {
        const int row0 = u.pm * 256 + wr * 64 + fr;
        const int pn = u.pn;
        if (pn < 8) {
            const int d0 = 64 * pn + 16 * wc + 4 * fq;
            const f32x4 baf = *(const f32x4*)(b_a + d0), bab = *(const f32x4*)(b_a + 512 + d0);
#pragma unroll
            for (int ai = 0; ai < 2; ++ai) {
                f32x4 pf[4], pb[4];
#pragma unroll
                for (int m = 0; m < 4; ++m) {
                    const f32x4 xf = acc[ai][1][m][0] + baf, xb = acc[ai][1][m][1] + bab;
#pragma unroll
                    for (int j = 0; j < 4; ++j) { pf[m][j] = (fminf(xf[j], 0.f) - __logf(1.0f + __expf(-fabsf(xf[j])))) * 0.0625f; pb[m][j] = (fminf(xb[j], 0.f) - __logf(1.0f + __expf(-fabsf(xb[j])))) * 0.0625f; }
                }
                f32x4 lb[4];
#pragma unroll
                for (int m = 0; m < 4; ++m) lb[m] = pb[m];
#pragma unroll
                for (int dl = 1; dl < 16; dl <<= 1) {
#pragma unroll
                    for (int m = 0; m < 4; ++m)
#pragma unroll
                        for (int j = 0; j < 4; ++j) { const float tf = __shfl_up(pf[m][j], dl, 16), tb = __shfl_up(pb[m][j], dl, 16); if (fr >= dl) { pf[m][j] += tf; pb[m][j] += tb; } }
                }
                f32x4 of = (f32x4){0.f, 0.f, 0.f, 0.f}, ob = of;
#pragma unroll
                for (int m = 0; m < 4; ++m)
#pragma unroll
                    for (int j = 0; j < 4; ++j) { const float tf = __shfl(pf[m][j], 15, 16), tb = __shfl(pb[m][j], 15, 16); pf[m][j] += of[j]; pb[m][j] += ob[j]; of[j] += tf; ob[j] += tb; }
                const int rbase = row0 + ai * 128;
                if (fr == 0) { const int chunk = (u.pm * 256 + ai * 128 + wr * 64) >> 6; f32x4 e0, e1;
#pragma unroll
                    for (int j = 0; j < 4; ++j) { e0[j] = __expf(of[j]); e1[j] = __expf(ob[j]); }
                    *(f32x4*)(ET + ((size_t)chunk * 2 + 0) * 512 + d0) = e0; *(f32x4*)(ET + ((size_t)chunk * 2 + 1) * 512 + d0) = e1; }
#pragma unroll
                for (int m = 0; m < 4; ++m) {
                    const f32x4 q = acc[ai][0][m][0] * 0.08838834764831845f, k = acc[ai][0][m][1];
                    f32x4 qf, kf, qb, kb;
#pragma unroll
                    for (int j = 0; j < 4; ++j) { const float bfw = pf[m][j], bbw = ob[j] - pb[m][j] + lb[m][j];
                        const float ef = __expf(bfw), eb = __expf(bbw);
                        qf[j] = q[j] * ef; kf[j] = k[j] * __builtin_amdgcn_rcpf(ef); qb[j] = q[j] * eb; kb[j] = k[j] * __builtin_amdgcn_rcpf(eb); }
                    const size_t off = (size_t)(rbase + m * 16) * 512 + d0;
                    u32x2 w;
                    w.x = cvt_pk_bf16(qf[0], qf[1]); w.y = cvt_pk_bf16(qf[2], qf[3]); *(u32x2*)(QDf + off) = w;
                    w.x = cvt_pk_bf16(kf[0], kf[1]); w.y = cvt_pk_bf16(kf[2], kf[3]); *(u32x2*)(KIf + off) = w;
                    w.x = cvt_pk_bf16(qb[0], qb[1]); w.y = cvt_pk_bf16(qb[2], qb[3]); *(u32x2*)(QDb + off) = w;
                    w.x = cvt_pk_bf16(kb[0], kb[1]); w.y = cvt_pk_bf16(kb[2], kb[3]); *(u32x2*)(KIb + off) = w;
                }
            }
        } else {
            const int col0 = (pn - 8) * 256 + wc * 32 + 8 * fq;
            f32x4 bv[2][2];
#pragma unroll
            for (int bj = 0; bj < 2; ++bj)
#pragma unroll
                for (int n = 0; n < 2; ++n) bv[bj][n] = *(const f32x4*)(b_r + col0 + bj * 128 + n * 4);
#pragma unroll
            for (int ai = 0; ai < 2; ++ai)
#pragma unroll
                for (int m = 0; m < 4; ++m) { bf16_t* rowp = R + (size_t)(row0 + ai * 128 + m * 16) * 1024 + col0;
#pragma unroll
                    for (int bj = 0; bj < 2; ++bj) { f32x4 v0 = acc[ai][bj][m][0] + bv[bj][0], v1 = acc[ai][bj][m][1] + bv[bj][1];
#pragma unroll
                        for (int j = 0; j < 4; ++j) { v0[j] = silu_f(v0[j]); v1[j] = silu_f(v1[j]); }
                        *(u32x4*)(rowp + bj * 128) = PACK8(v0, v1); } }
        }
    }
};
struct EpiDelta {
    bf16_t* D; const float* gate; bf16_t* Dp; int split;
    __device__ __forceinline__ void operator()(const AccT& acc, const Unit& u, int wr, int wc, int fr, int fq) const {
        const int rt = u.pm * 256; const int b = rt >= TL ? 16 : (rt >> 11);
        const int colt = u.pn * 256 + wc * 32 + 8 * fq;
        const float* gp = gate + (size_t)b * NADA + colt;
        f32x4 gv[2][2];
#pragma unroll
        for (int bj = 0; bj < 2; ++bj)
#pragma unroll
            for (int n = 0; n < 2; ++n) gv[bj][n] = *(const f32x4*)(gp + bj * 128 + n * 4);
#pragma unroll
        for (int ai = 0; ai < 2; ++ai)
#pragma unroll
            for (int m = 0; m < 4; ++m) { bf16_t* rowp = (split && rt >= TL ? Dp + (size_t)u.part * TC * DM + (size_t)(rt - TL + wr * 64 + fr + ai * 128 + m * 16) * DM : D + (size_t)(rt + wr * 64 + fr + ai * 128 + m * 16) * DM) + colt;
#pragma unroll
                for (int bj = 0; bj < 2; ++bj) { const f32x4 v0 = gv[bj][0] * acc[ai][bj][m][0], v1 = gv[bj][1] * acc[ai][bj][m][1]; *(u32x4*)(rowp + bj * 128) = PACK8(v0, v1); } }
    }
};
struct EpiConvIn {
    bf16_t* PU;
    __device__ __forceinline__ void operator()(const AccT& acc, const Unit& u, int wr, int wc, int fr, int fq) const {
        const int row0 = u.pm * 256 + wr * 64 + fr;
        if (u.pn < 4) {
            const int col0 = u.pn * 256 + wc * 32 + 8 * fq;
#pragma unroll
            for (int ai = 0; ai < 2; ++ai)
#pragma unroll
                for (int m = 0; m < 4; ++m) { bf16_t* rowp = PU + (size_t)(row0 + ai * 128 + m * 16) * 2048 + col0;
#pragma unroll
                    for (int bj = 0; bj < 2; ++bj) *(u32x4*)(rowp + bj * 128) = PACK8(acc[ai][bj][m][0], acc[ai][bj][m][1]); }
        } else {
            const int col0 = 1024 + (u.pn - 4) * 128 + wc * 32 + 8 * fq;
#pragma unroll
            for (int ai = 0; ai < 2; ++ai)
#pragma unroll
                for (int m = 0; m < 4; ++m) { bf16_t* rowp = PU + (size_t)(row0 + ai * 128 + m * 16) * 2048 + col0;
                    const f32x4 v0 = acc[ai][0][m][0] * acc[ai][1][m][0], v1 = acc[ai][0][m][1] * acc[ai][1][m][1];
                    *(u32x4*)(rowp) = PACK8(v0, v1); }
        }
    }
};
struct EpiSwiglu {
    bf16_t* F;
    __device__ __forceinline__ void operator()(const AccT& acc, const Unit& u, int wr, int wc, int fr, int fq) const {
        const int row0 = u.pm * 256 + wr * 64 + fr, col0 = u.pn * 128 + wc * 32 + 8 * fq;
#pragma unroll
        for (int ai = 0; ai < 2; ++ai)
#pragma unroll
            for (int m = 0; m < 4; ++m) { bf16_t* rowp = F + (size_t)(row0 + ai * 128 + m * 16) * DFF + col0;
                f32x4 v0, v1;
#pragma unroll
                for (int j = 0; j < 4; ++j) { v0[j] = silu_f(acc[ai][0][m][0][j]) * acc[ai][1][m][0][j]; v1[j] = silu_f(acc[ai][0][m][1][j]) * acc[ai][1][m][1][j]; }
                *(u32x4*)(rowp) = PACK8(v0, v1); }
    }
};

__device__ __forceinline__ void ada_phase(LAS unsigned char* lds, const Params& P) {
    LAS float* sc = (LAS float*)lds;
    LAS float* red = sc + NCOND * 1024;
    const int tid = opaque_tid(), wave = tid >> 6, lane = tid & 63;
    const float* c = P.in[I_C]; const float* cctx = P.in[I_CCTX]; const float* adaw = P.in[I_ADAW]; const float* adab = P.in[I_ADAB];
    float* mod = (float*)(P.ws + WS_MOD);
    if ((int)blockIdx.x >= 192) return;
    for (int idx = tid; idx < NCOND * 1024; idx += 512) { const int b = idx >> 10, k = idx & 1023; const float v = b < 16 ? c[b * 1024 + k] : cctx[k]; sc[idx] = silu_f(v); }
    __syncthreads();
    for (int item = blockIdx.x; item < 192; item += gridDim.x) {
        const int l = item / 48, n0 = (item % 48) * 128;
        float acc[NCOND][2];
#pragma unroll
        for (int b = 0; b < NCOND; ++b) { acc[b][0] = 0.f; acc[b][1] = 0.f; }
        const float* wbase = adaw + ((size_t)l * 1024) * NADA + n0 + 2 * lane;
        for (int k = 128 * wave; k < 128 * wave + 128; k += 16) {
            f32x2 wv[16];
#pragma unroll
            for (int i = 0; i < 16; ++i) wv[i] = __builtin_nontemporal_load((const f32x2*)(wbase + (size_t)(k + i) * NADA));
#pragma unroll
            for (int b = 0; b < NCOND; ++b) {
#pragma unroll
                for (int kk = 0; kk < 16; kk += 4) { const f32x4 s4 = *(const LAS f32x4*)(sc + b * 1024 + k + kk);
                    acc[b][0] += s4[0] * wv[kk][0] + s4[1] * wv[kk + 1][0] + s4[2] * wv[kk + 2][0] + s4[3] * wv[kk + 3][0];
                    acc[b][1] += s4[0] * wv[kk][1] + s4[1] * wv[kk + 1][1] + s4[2] * wv[kk + 2][1] + s4[3] * wv[kk + 3][1]; } }
        }
#pragma unroll
        for (int b = 0; b < NCOND; ++b) { red[(wave * NCOND + b) * 128 + 2 * lane] = acc[b][0]; red[(wave * NCOND + b) * 128 + 2 * lane + 1] = acc[b][1]; }
        __syncthreads();
        for (int idx = tid; idx < NCOND * 128; idx += 512) { const int b = idx >> 7, cc = idx & 127; float s = 0.f;
#pragma unroll
            for (int w = 0; w < 8; ++w) s += red[(w * NCOND + b) * 128 + cc];
            mod[((size_t)l * NCOND + b) * NADA + n0 + cc] = s + adab[l * NADA + n0 + cc]; }
        __syncthreads();
    }
}

__host__ __device__ __forceinline__ int qkl_row(int type, int d) { return 256 * (d >> 6) + 128 * (type >> 1) + 32 * ((d >> 4) & 3) + 8 * ((d >> 2) & 3) + 4 * (type & 1) + (d & 3); }
__device__ __forceinline__ void transpose_item(const float* W, int K, int N, bf16_t* WT, int wt_row0, int k0, int n0, LAS float* scr, int lane, int qkl_type = -1) {
#pragma unroll 8
    for (int i = 0; i < 32; ++i) { const int kk = 2 * i + (lane >> 5); scr[kk * 33 + (lane & 31)] = __builtin_nontemporal_load(W + (size_t)(k0 + kk) * N + n0 + (lane & 31)); }
    LDS_WAIT(); asm volatile("" ::: "memory");
    const int c = lane & 7;
#pragma unroll
    for (int j = 0; j < 4; ++j) { const int n = (lane >> 3) + 8 * j; const LAS float* s = scr + (8 * c) * 33 + n;
        u32x4 o; o.x = cvt_pk_bf16(s[0 * 33], s[1 * 33]); o.y = cvt_pk_bf16(s[2 * 33], s[3 * 33]); o.z = cvt_pk_bf16(s[4 * 33], s[5 * 33]); o.w = cvt_pk_bf16(s[6 * 33], s[7 * 33]);
        const int drow = qkl_type >= 0 ? qkl_row(qkl_type, wt_row0 + n) : wt_row0 + n;
        *(u32x4*)(WT + (size_t)drow * K + k0 + 8 * c) = o; }
    LDS_WAIT(); asm volatile("" ::: "memory");
}
__device__ __forceinline__ void prep_layer(LAS unsigned char* lds, const Params& P, int layer, int c0, int nblk) {
    const int tid = opaque_tid(), wave = tid >> 6, lane = tid & 63;
    const int kind = layer & 1, j = layer >> 1;
    LAS float* scr = (LAS float*)(lds + wave * 8704);
    unsigned char* wb = P.ws + ((layer & 1) ? WS_W2 : 0);
    bf16_t* Win_t = (bf16_t*)(wb + WS_WIN); bf16_t* Wout_t = (bf16_t*)(wb + WS_WOUT); bf16_t* Wf1_t = (bf16_t*)(wb + WS_WF1); bf16_t* Wf2_t = (bf16_t*)(wb + WS_WF2);
    const float* Win = (kind == 0 ? P.in[I_CWIN] : P.in[I_GWIN]) + (size_t)j * 1024 * 3072;
    const float* Wout = (kind == 0 ? P.in[I_CWOUT] : P.in[I_GWOUT]) + (size_t)j * 1024 * 1024;
    const float* Wf1 = P.in[I_FWIN] + (size_t)layer * 1024 * 5632;
    const float* Wf2 = P.in[I_FWOUT] + (size_t)layer * 2816 * 1024;
    const int gw = ((int)blockIdx.x - c0) * 8 + wave, NGW = nblk * 8;
    for (int it = gw; it < 6272; it += NGW) {
        if (it < 1536) { const int kb = it / 96, n0 = (it % 96) * 32;
            if (kind == 0) { const int row0 = n0 < 1024 ? n0 : (n0 < 2048 ? 1024 + 256 * ((n0 - 1024) / 128) + ((n0 - 1024) % 128) : 1024 + 256 * ((n0 - 2048) / 128) + 128 + ((n0 - 2048) % 128));
                transpose_item(Win, 1024, 3072, Win_t, row0, kb * 64, n0, scr, lane); }
            else if (n0 < 1024) transpose_item(Win, 1024, 3072, Win_t, n0 & 511, kb * 64, n0, scr, lane, n0 >> 9);
            else transpose_item(Win, 1024, 3072, Win_t, n0 < 2048 ? n0 + 2048 : n0, kb * 64, n0, scr, lane); }
        else if (it < 2048) { const int r = it - 1536; const int kb = r / 32, n0 = (r % 32) * 32; transpose_item(Wout, 1024, 1024, Wout_t, n0, kb * 64, n0, scr, lane); }
        else if (it < 4864) { const int r = it - 2048; const int kb = r / 176, n0 = (r % 176) * 32;
            const int row0 = n0 < 2816 ? 256 * (n0 / 128) + (n0 % 128) : 256 * ((n0 - 2816) / 128) + 128 + ((n0 - 2816) % 128);
            transpose_item(Wf1, 1024, 5632, Wf1_t, row0, kb * 64, n0, scr, lane); }
        else { const int r = it - 4864; const int kb = r / 32, n0 = (r % 32) * 32; transpose_item(Wf2, 2816, 1024, Wf2_t, n0, kb * 64, n0, scr, lane); }
    }
    if (kind == 1) {
        const float* a1 = P.in[I_GA1] + (size_t)j * 2 * 1024 * 16; const float* a2 = P.in[I_GA2] + (size_t)j * 2 * 16 * 512;
        const int gt = ((int)blockIdx.x - c0) * 512 + tid, NT = nblk * 512;
        for (int idx = gt; idx < 1024 * 128; idx += NT) {
            const int row = idx >> 7, kg = idx & 127, dir = row >> 9, d = row & 511;
            float a2v[16];
#pragma unroll
            for (int r = 0; r < 16; ++r) a2v[r] = a2[((size_t)dir * 16 + r) * 512 + d];
            float o[8];
#pragma unroll
            for (int kk = 0; kk < 8; ++kk) { const f32x4* ar = (const f32x4*)(a1 + ((size_t)dir * 1024 + 8 * kg + kk) * 16); float s = 0.f;
#pragma unroll
                for (int q = 0; q < 4; ++q) { const f32x4 av = ar[q]; s += av[0] * a2v[4 * q] + av[1] * a2v[4 * q + 1] + av[2] * a2v[4 * q + 2] + av[3] * a2v[4 * q + 3]; }
                o[kk] = s; }
            u32x4 w; w.x = cvt_pk_bf16(o[0], o[1]); w.y = cvt_pk_bf16(o[2], o[3]); w.z = cvt_pk_bf16(o[4], o[5]); w.w = cvt_pk_bf16(o[6], o[7]);
            *(u32x4*)(Win_t + (size_t)qkl_row(2 + dir, d) * 1024 + 8 * kg) = w;
        }
    }
}

__device__ __forceinline__ void norm_mod_phase(const float* src_lat, const float* src_ctx, const bf16_t* delta, const bf16_t* dparts, float* xo_lat, float* xo_ctx,
                                               const float* gain, const float* modl, int shoff, int scoff, bf16_t* H, int nrows) {
    const int tid = opaque_tid(), wave = tid >> 6, lane = tid & 63;
    const int gw = blockIdx.x * 8 + wave, NGW = gridDim.x * 8;
    for (int r0 = gw * 4; r0 < nrows; r0 += NGW * 4) {
        const float* xrow = r0 < TL ? src_lat + (size_t)r0 * DM : src_ctx + (size_t)(r0 - TL) * DM; const int b = r0 < TL ? (r0 >> 11) : 16;
        float* xout = r0 < TL ? xo_lat + (size_t)r0 * DM : xo_ctx + (size_t)(r0 - TL) * DM;
        f32x4 v[4][4]; float ss[4];
#pragma unroll
        for (int i = 0; i < 4; ++i)
#pragma unroll
            for (int q = 0; q < 4; ++q) v[i][q] = __builtin_nontemporal_load((const f32x4*)(xrow + (size_t)i * DM) + lane + 64 * q);
        if (delta) {
            const int np = (dparts && r0 >= TL) ? 4 : 1;
            for (int p = 0; p < np; ++p) {
                const bf16_t* dsrc = np == 4 ? dparts + (size_t)p * TC * DM + (size_t)(r0 - TL) * DM : delta + (size_t)r0 * DM;
                u32x2 dv[4][4];
#pragma unroll
                for (int i = 0; i < 4; ++i)
#pragma unroll
                    for (int q = 0; q < 4; ++q) dv[i][q] = __builtin_nontemporal_load((const u32x2*)(dsrc + (size_t)i * DM + 4 * lane + 256 * q));
#pragma unroll
                for (int i = 0; i < 4; ++i)
#pragma unroll
                    for (int q = 0; q < 4; ++q) { v[i][q][0] += bf2f((unsigned short)(dv[i][q].x & 0xffff)); v[i][q][1] += bf2f((unsigned short)(dv[i][q].x >> 16));
                        v[i][q][2] += bf2f((unsigned short)(dv[i][q].y & 0xffff)); v[i][q][3] += bf2f((unsigned short)(dv[i][q].y >> 16)); }
            }
        }
#pragma unroll
        for (int i = 0; i < 4; ++i)
#pragma unroll
            for (int q = 0; q < 4; ++q) { if (xo_lat) __builtin_nontemporal_store(v[i][q], (f32x4*)(xout + (size_t)i * DM) + lane + 64 * q); }
        const float* mb = modl + (size_t)b * NADA;
        f32x4 g4[4], sc4[4], sh4[4];
#pragma unroll
        for (int q = 0; q < 4; ++q) { const int col = 4 * lane + 256 * q; g4[q] = *(const f32x4*)(gain + col); sc4[q] = *(const f32x4*)(mb + scoff + col) + 1.0f; sh4[q] = *(const f32x4*)(mb + shoff + col); }
#pragma unroll
        for (int i = 0; i < 4; ++i) { float s = 0.f;
#pragma unroll
            for (int q = 0; q < 4; ++q) s += (v[i][q][0] * v[i][q][0] + v[i][q][1] * v[i][q][1]) + (v[i][q][2] * v[i][q][2] + v[i][q][3] * v[i][q][3]);
            ss[i] = s; }
#pragma unroll
        for (int o = 1; o < 64; o <<= 1) {
#pragma unroll
            for (int i = 0; i < 4; ++i) ss[i] += __shfl_xor(ss[i], o); }
#pragma unroll
        for (int i = 0; i < 4; ++i) { const float rstd = rsqrtf(ss[i] * (1.0f / DM) + 1e-6f);
#pragma unroll
            for (int q = 0; q < 4; ++q) { const int col = 4 * lane + 256 * q; const f32x4 h = (v[i][q] * rstd * g4[q]) * sc4[q] + sh4[q];
                u32x2 w; w.x = cvt_pk_bf16(h[0], h[1]); w.y = cvt_pk_bf16(h[2], h[3]); *(u32x2*)(H + (size_t)(r0 + i) * DM + col) = w; } }
    }
}
__device__ __forceinline__ void final_norm_phase(const float* X, const bf16_t* delta, const float* gain, float* out) {
    const int tid = opaque_tid(), wave = tid >> 6, lane = tid & 63;
    const int gw = blockIdx.x * 8 + wave, NGW = gridDim.x * 8;
    for (int r0 = gw * 4; r0 < TL; r0 += NGW * 4) {
        f32x4 v[4][4]; float ss[4]; u32x2 dv[4][4];
#pragma unroll
        for (int i = 0; i < 4; ++i)
#pragma unroll
            for (int q = 0; q < 4; ++q) { v[i][q] = __builtin_nontemporal_load((const f32x4*)(X + (size_t)(r0 + i) * DM) + lane + 64 * q); dv[i][q] = __builtin_nontemporal_load((const u32x2*)(delta + (size_t)(r0 + i) * DM + 4 * lane + 256 * q)); }
        f32x4 g4[4];
#pragma unroll
        for (int q = 0; q < 4; ++q) g4[q] = *(const f32x4*)(gain + 4 * lane + 256 * q);
#pragma unroll
        for (int i = 0; i < 4; ++i) { float s = 0.f;
#pragma unroll
            for (int q = 0; q < 4; ++q) { v[i][q][0] += bf2f((unsigned short)(dv[i][q].x & 0xffff)); v[i][q][1] += bf2f((unsigned short)(dv[i][q].x >> 16));
                v[i][q][2] += bf2f((unsigned short)(dv[i][q].y & 0xffff)); v[i][q][3] += bf2f((unsigned short)(dv[i][q].y >> 16));
                s += (v[i][q][0] * v[i][q][0] + v[i][q][1] * v[i][q][1]) + (v[i][q][2] * v[i][q][2] + v[i][q][3] * v[i][q][3]); }
            ss[i] = s; }
#pragma unroll
        for (int o = 1; o < 64; o <<= 1) {
#pragma unroll
            for (int i = 0; i < 4; ++i) ss[i] += __shfl_xor(ss[i], o); }
#pragma unroll
        for (int i = 0; i < 4; ++i) { const float rstd = rsqrtf(ss[i] * (1.0f / DM) + 1e-6f);
#pragma unroll
            for (int q = 0; q < 4; ++q) __builtin_nontemporal_store(v[i][q] * rstd * g4[q], (f32x4*)(out + (size_t)(r0 + i) * DM + 4 * lane + 256 * q)); }
    }
}
__device__ __forceinline__ void conv_phase(const bf16_t* PU, const float* cw, bf16_t* Z, int ntok) {
    const int gt = blockIdx.x * 512 + opaque_tid(), NT = gridDim.x * 512;
    const int total = (ntok >> 3) * 128;
    for (int idx = gt; idx < total; idx += NT) {
        const int t0 = (idx >> 7) * 8, cg8 = (idx & 127) * 8;
        int pos0, len; if (t0 < TL) { pos0 = t0 & 63; len = 64; } else { pos0 = (t0 - TL) & 255; len = 256; }
        const bf16_t* row = PU + (size_t)t0 * 2048 + cg8;
        const bool hasp = pos0 > 0, hasn = pos0 + 8 < len;
        u32x4 gbv[8], uv[10];
        const u32x4 z4 = (u32x4){0, 0, 0, 0};
        uv[0] = z4; uv[9] = z4;
        if (hasp) uv[0] = __builtin_nontemporal_load((const u32x4*)(row - 2048 + 1024));
#pragma unroll
        for (int i = 0; i < 8; ++i) { gbv[i] = __builtin_nontemporal_load((const u32x4*)(row + (size_t)i * 2048)); uv[i + 1] = __builtin_nontemporal_load((const u32x4*)(row + (size_t)i * 2048 + 1024)); }
        if (hasn) uv[9] = __builtin_nontemporal_load((const u32x4*)(row + (size_t)8 * 2048 + 1024));
        float w0[8], w1[8], w2[8];
#pragma unroll
        for (int e = 0; e < 8; ++e) { w0[e] = cw[cg8 + e]; w1[e] = cw[1024 + cg8 + e]; w2[e] = cw[2048 + cg8 + e]; }
#pragma unroll
        for (int i = 0; i < 8; ++i) {
            float o[8];
#pragma unroll
            for (int q = 0; q < 4; ++q) {
                const float gb0 = bf2f((unsigned short)(gbv[i][q] & 0xffff)), gb1 = bf2f((unsigned short)(gbv[i][q] >> 16));
                const float p0 = bf2f((unsigned short)(uv[i][q] & 0xffff)), p1 = bf2f((unsigned short)(uv[i][q] >> 16));
                const float c0 = bf2f((unsigned short)(uv[i + 1][q] & 0xffff)), c1 = bf2f((unsigned short)(uv[i + 1][q] >> 16));
                const float n0 = bf2f((unsigned short)(uv[i + 2][q] & 0xffff)), n1 = bf2f((unsigned short)(uv[i + 2][q] >> 16));
                o[2 * q] = gb0 * (w0[2 * q] * p0 + w1[2 * q] * c0 + w2[2 * q] * n0);
                o[2 * q + 1] = gb1 * (w0[2 * q + 1] * p1 + w1[2 * q + 1] * c1 + w2[2 * q + 1] * n1); }
            u32x4 w; w.x = cvt_pk_bf16(o[0], o[1]); w.y = cvt_pk_bf16(o[2], o[3]); w.z = cvt_pk_bf16(o[4], o[5]); w.w = cvt_pk_bf16(o[6], o[7]);
            *(u32x4*)(Z + (size_t)(t0 + i) * DM + cg8) = w;
        }
    }
}
__device__ __forceinline__ void gla_out_phase(const bf16_t* Of, const bf16_t* Ob, const bf16_t* R, const float* ng, bf16_t* G, int ntok) {
    const int tid = opaque_tid(), wave = tid >> 6, lane = tid & 63;
    const int gw = blockIdx.x * 8 + wave, NGW = gridDim.x * 8;
    const float* ngp = ng + ((16 * lane) & 255);
    float ngv[16];
#pragma unroll
    for (int e = 0; e < 16; ++e) ngv[e] = ngp[e];
    for (int t0 = gw * 2; t0 < ntok; t0 += NGW * 2) {
        u32x4 av[2][2], bv[2][2], rv[2][2];
#pragma unroll
        for (int i = 0; i < 2; ++i) { const size_t off = (size_t)(t0 + i) * DM + 16 * lane;
            av[i][0] = __builtin_nontemporal_load((const u32x4*)(Of + off)); av[i][1] = __builtin_nontemporal_load((const u32x4*)(Of + off + 8)); bv[i][0] = __builtin_nontemporal_load((const u32x4*)(Ob + off)); bv[i][1] = __builtin_nontemporal_load((const u32x4*)(Ob + off + 8));
            rv[i][0] = __builtin_nontemporal_load((const u32x4*)(R + off)); rv[i][1] = __builtin_nontemporal_load((const u32x4*)(R + off + 8)); }
#pragma unroll
        for (int i = 0; i < 2; ++i) {
            float o[16]; float s = 0.f;
#pragma unroll
            for (int hh = 0; hh < 2; ++hh)
#pragma unroll
                for (int q = 0; q < 4; ++q) {
                    o[8 * hh + 2 * q] = bf2f((unsigned short)(av[i][hh][q] & 0xffff)) + bf2f((unsigned short)(bv[i][hh][q] & 0xffff));
                    o[8 * hh + 2 * q + 1] = bf2f((unsigned short)(av[i][hh][q] >> 16)) + bf2f((unsigned short)(bv[i][hh][q] >> 16)); }
#pragma unroll
            for (int e = 0; e < 16; ++e) s += o[e] * o[e];
            s += __shfl_xor(s, 1); s += __shfl_xor(s, 2); s += __shfl_xor(s, 4); s += __shfl_xor(s, 8);
            const float rstd = rsqrtf(s * (1.0f / 256.0f) + 1e-6f);
            float y[16];
#pragma unroll
            for (int hh = 0; hh < 2; ++hh)
#pragma unroll
                for (int q = 0; q < 4; ++q) {
                    y[8 * hh + 2 * q] = o[8 * hh + 2 * q] * rstd * ngv[8 * hh + 2 * q] * bf2f((unsigned short)(rv[i][hh][q] & 0xffff));
                    y[8 * hh + 2 * q + 1] = o[8 * hh + 2 * q + 1] * rstd * ngv[8 * hh + 2 * q + 1] * bf2f((unsigned short)(rv[i][hh][q] >> 16)); }
            u32x4 w0, w1;
            w0.x = cvt_pk_bf16(y[0], y[1]); w0.y = cvt_pk_bf16(y[2], y[3]); w0.z = cvt_pk_bf16(y[4], y[5]); w0.w = cvt_pk_bf16(y[6], y[7]);
            w1.x = cvt_pk_bf16(y[8], y[9]); w1.y = cvt_pk_bf16(y[10], y[11]); w1.z = cvt_pk_bf16(y[12], y[13]); w1.w = cvt_pk_bf16(y[14], y[15]);
            const size_t off = (size_t)(t0 + i) * DM + 16 * lane;
            *(u32x4*)(G + off) = w0; *(u32x4*)(G + off + 8) = w1;
        }
    }
}

constexpr int SC_QD = 0, SC_KI = 17408, SC_KDT = 34816, SC_VT = 53248, SC_ST = 71680, SC_P = 106496, SC_TOT = 115712, SC_DEC = 117760, SC_LA = 118272  ;
constexpr int PQ = 136, PS = 72;
__device__ __forceinline__ void gla_scan_phase(LAS unsigned char* lds, const bf16_t* QDf, const bf16_t* KIf, const bf16_t* QDb, const bf16_t* KIb, const float* ET, const bf16_t* VT, bf16_t* Of, bf16_t* Ob) {
    const int tid = opaque_tid(), w = __builtin_amdgcn_readfirstlane(tid >> 6), lane = tid & 63, fr = lane & 15, fq = lane >> 4;
    LAS bf16_t* QD = (LAS bf16_t*)(lds + SC_QD); LAS bf16_t* KI = (LAS bf16_t*)(lds + SC_KI); LAS bf16_t* KDT = (LAS bf16_t*)(lds + SC_KDT);
    LAS bf16_t* VTs = (LAS bf16_t*)(lds + SC_VT); LAS bf16_t* ST = (LAS bf16_t*)(lds + SC_ST); LAS bf16_t* Pm = (LAS bf16_t*)(lds + SC_P);
    LAS float* TOT = (LAS float*)(lds + SC_TOT); LAS float* DEC = (LAS float*)(lds + SC_DEC);
    const int d = tid & 127, seg = tid >> 7;
    for (int item = blockIdx.x; item < 256; item += gridDim.x) {
        const int es = item & 1, dir = (item >> 1) & 1, h = (item >> 2) & 3, b = item >> 4;
        bf16_t* Od = dir ? Ob : Of;
        for (int i = tid; i < 128 * PQ / 2; i += 512) ((LAS unsigned*)ST)[i] = 0u;
        f32x4 S[8];
#pragma unroll
        for (int dt = 0; dt < 8; ++dt) S[dt] = (f32x4){0.f, 0.f, 0.f, 0.f};
        __syncthreads();
        const bf16_t* QDg = dir ? QDb : QDf; const bf16_t* KIg = dir ? KIb : KIf;
        u32x4 qv[2][2], kv[2][2], vtv[2][2]; f32x4 etv[2][2][2]; float decv[2] = {0.f, 0.f};
        const int krow = tid & 63, kc8 = (tid >> 6) * 8;
#define SCAN_TOK0(st) ((st) < 4 ? (TL + b * 256 + (dir ? 3 - (st) : (st)) * 64) : (b * 2048 + (dir ? 31 - ((st) - 4) : ((st) - 4)) * 64))
#define SCAN_LOAD(st, S) do { const int _t0 = SCAN_TOK0(st); const float* _et = ET + ((size_t)(_t0 >> 6) * 2 + dir) * 512 + h * 128; \
            _Pragma("unroll") for (int i = 0; i < 2; ++i) { const int piece = tid + 512 * i; const int row = piece >> 4, c8 = (piece & 15) * 8; \
                qv[S][i] = *(const u32x4*)(QDg + (size_t)(_t0 + row) * 512 + h * 128 + c8); \
                kv[S][i] = *(const u32x4*)(KIg + (size_t)(_t0 + krow) * 512 + h * 128 + kc8 + 64 * i); \
                etv[S][i][0] = *(const f32x4*)(_et + kc8 + 64 * i); etv[S][i][1] = *(const f32x4*)(_et + kc8 + 64 * i + 4); \
                const int er = piece >> 3, pc = piece & 7; vtv[S][i] = *(const u32x4*)(VT + (size_t)(h * 256 + es * 128 + er) * TT + _t0 + 8 * pc); } \
            if (tid < 128) decv[S] = _et[tid]; } while (0)
        SCAN_LOAD(0, 0); SCAN_LOAD(1, 1);
        for (int step2 = 0; step2 < 36; step2 += 2) {
#pragma unroll
          for (int ss = 0; ss < 2; ++ss) {
            const int step = step2 + ss;
            const int tok0 = SCAN_TOK0(step);
#pragma unroll
            for (int i = 0; i < 2; ++i) { const int piece = tid + 512 * i; const int row = piece >> 4, c8 = (piece & 15) * 8;
                *(LAS u32x4*)(QD + row * PQ + c8) = qv[ss][i];
                *(LAS u32x4*)(KI + krow * PQ + kc8 + 64 * i) = kv[ss][i];
                const f32x4 e0 = etv[ss][i][0], e1 = etv[ss][i][1];
#pragma unroll
                for (int q = 0; q < 4; ++q) { const float klo = bf2f((unsigned short)(kv[ss][i][q] & 0xffff)), khi = bf2f((unsigned short)(kv[ss][i][q] >> 16));
                    const float elo = (2 * q < 4) ? e0[(2 * q) & 3] : e1[(2 * q) & 3], ehi = (2 * q + 1 < 4) ? e0[(2 * q + 1) & 3] : e1[(2 * q + 1) & 3];
                    KDT[(kc8 + 64 * i + 2 * q) * PS + krow] = f2bf(klo * elo); KDT[(kc8 + 64 * i + 2 * q + 1) * PS + krow] = f2bf(khi * ehi); }
                const int er = piece >> 3, pc = piece & 7; *(LAS u32x4*)(VTs + er * PS + 8 * pc) = vtv[ss][i]; }
            if (tid < 128) DEC[tid] = decv[ss];
            __syncthreads();
            if (step + 2 < 36) SCAN_LOAD(step + 2, ss);
#define FRAG(base, row, pitch, ks) (*(const LAS bf16x8*)((base) + (row) * (pitch) + (ks) * 32 + fq * 8))
            {
                const int id0 = 2 * w, ct0 = id0 >> 2, st0 = id0 & 3, st1 = st0 + 1;
                bf16x8 qa[4], kb0[4], kb1[4];
#pragma unroll
                for (int ks = 0; ks < 4; ++ks) { qa[ks] = FRAG(QD, ct0 * 16 + fr, PQ, ks); kb0[ks] = FRAG(KI, st0 * 16 + fr, PQ, ks); kb1[ks] = FRAG(KI, st1 * 16 + fr, PQ, ks); }
                bf16x8 sa[4];
#pragma unroll
                for (int ks = 0; ks < 4; ++ks) sa[ks] = FRAG(ST, 16 * w + fr, PQ, ks);
#pragma unroll
                for (int dt = 0; dt < 8; ++dt) { const f32x4 dcv = *(const LAS f32x4*)(DEC + 16 * dt + 4 * fq); S[dt] = S[dt] * dcv; }
                __builtin_amdgcn_sched_barrier(0);
                f32x4 a0 = (f32x4){0.f, 0.f, 0.f, 0.f}, a1 = a0;
#pragma unroll
                for (int ks = 0; ks < 4; ++ks) { a0 = __builtin_amdgcn_mfma_f32_16x16x32_bf16(qa[ks], kb0[ks], a0, 0, 0, 0); a1 = __builtin_amdgcn_mfma_f32_16x16x32_bf16(qa[ks], kb1[ks], a1, 0, 0, 0); }
#pragma unroll
                for (int rg = 0; rg < 4; ++rg) { const int c_ = ct0 * 16 + 4 * fq + rg; const int s0_ = st0 * 16 + fr, s1_ = st1 * 16 + fr;
                    const bool k0_ = dir == 0 ? (s0_ <= c_) : (s0_ >= c_), k1_ = dir == 0 ? (s1_ <= c_) : (s1_ >= c_);
                    Pm[c_ * PS + s0_] = k0_ ? f2bf(a0[rg]) : (bf16_t)0; Pm[c_ * PS + s1_] = k1_ ? f2bf(a1[rg]) : (bf16_t)0; }
                f32x4 oacc[4];
#pragma unroll
                for (int ct = 0; ct < 4; ++ct) oacc[ct] = (f32x4){0.f, 0.f, 0.f, 0.f};
#pragma unroll
                for (int ct = 0; ct < 4; ++ct) {
                    bf16x8 qb[4];
#pragma unroll
                    for (int ks = 0; ks < 4; ++ks) qb[ks] = FRAG(QD, 16 * ct + fr, PQ, ks);
#pragma unroll
                    for (int ks = 0; ks < 4; ++ks) oacc[ct] = __builtin_amdgcn_mfma_f32_16x16x32_bf16(sa[ks], qb[ks], oacc[ct], 0, 0, 0);
                }
                __syncthreads();
                bf16x8 va[2], pb[4][2];
#pragma unroll
                for (int ks = 0; ks < 2; ++ks) { va[ks] = FRAG(VTs, 16 * w + fr, PS, ks);
#pragma unroll
                    for (int ct = 0; ct < 4; ++ct) pb[ct][ks] = FRAG(Pm, 16 * ct + fr, PS, ks); }
                __builtin_amdgcn_sched_barrier(0);
#pragma unroll
                for (int ks = 0; ks < 2; ++ks)
#pragma unroll
                    for (int ct = 0; ct < 4; ++ct) oacc[ct] = __builtin_amdgcn_mfma_f32_16x16x32_bf16(va[ks], pb[ct][ks], oacc[ct], 0, 0, 0);
#pragma unroll
                for (int ct = 0; ct < 4; ++ct) { u32x2 wv; wv.x = cvt_pk_bf16(oacc[ct][0], oacc[ct][1]); wv.y = cvt_pk_bf16(oacc[ct][2], oacc[ct][3]);
                    *(u32x2*)(Od + (size_t)(tok0 + 16 * ct + fr) * DM + h * 256 + es * 128 + 16 * w + 4 * fq) = wv; }
#pragma unroll
                for (int half = 0; half < 2; ++half) {
                    bf16x8 ka[4][2];
#pragma unroll
                    for (int dd = 0; dd < 4; ++dd)
#pragma unroll
                        for (int ks = 0; ks < 2; ++ks) ka[dd][ks] = FRAG(KDT, 16 * (4 * half + dd) + fr, PS, ks);
                    __builtin_amdgcn_sched_barrier(0);
#pragma unroll
                    for (int ks = 0; ks < 2; ++ks)
#pragma unroll
                        for (int dd = 0; dd < 4; ++dd) S[4 * half + dd] = __builtin_amdgcn_mfma_f32_16x16x32_bf16(ka[dd][ks], va[ks], S[4 * half + dd], 0, 0, 0);
                }
#pragma unroll
                for (int dt = 0; dt < 8; ++dt) { u32x2 wv; wv.x = cvt_pk_bf16(S[dt][0], S[dt][1]); wv.y = cvt_pk_bf16(S[dt][2], S[dt][3]); *(LAS u32x2*)(ST + (16 * w + fr) * PQ + 16 * dt + 4 * fq) = wv; }
            }
#undef FRAG
            __syncthreads();
          }
        }
    }
}

#undef SCAN_LOAD
#undef SCAN_TOK0
__global__ void __launch_bounds__(512, 2) fwd_megakernel(Params P) {
    extern __shared__ __attribute__((aligned(16))) unsigned char lds_raw[];
    LAS unsigned char* lds = (LAS unsigned char*)lds_raw;
    cg::grid_group grid = cg::this_grid();
#define GSYNC0() do { asm volatile("s_waitcnt vmcnt(0) lgkmcnt(0)" ::: "memory"); __syncthreads(); grid.sync(); asm volatile("s_waitcnt vmcnt(0) lgkmcnt(0)" ::: "memory"); __syncthreads(); } while (0)
    volatile LAS unsigned* xb_st = (volatile LAS unsigned*)(lds + LDS_BYTES - 16);
    if (threadIdx.x == 0) { xb_st[0] = 0u; xb_st[1] = 0u; }
    __syncthreads();
    const XcdBarrier xbar = xcd_barrier_post((unsigned*)(P.ws + WS_CTL), xb_st);
    grid.sync();
#define GSYNC() xcd_barrier(xbar)
    const int G = gridDim.x, bx = blockIdx.x;
    unsigned char* ws = P.ws;
    float* mod = (float*)(ws + WS_MOD);
    float* Xl = P.out; float* Xc = (float*)(ws + WS_XCTX);
    bf16_t* HZ = (bf16_t*)(ws + WS_HZ); bf16_t* BIG = (bf16_t*)(ws + WS_BIG);
    bf16_t* QDf = (bf16_t*)(ws + WS_BIG); bf16_t* KIf = (bf16_t*)(ws + WS_BIG + 36 * MiB); bf16_t* QDb = (bf16_t*)(ws + WS_BIG + 72 * MiB); bf16_t* KIb = (bf16_t*)(ws + WS_BIG + 108 * MiB); bf16_t* VTb = (bf16_t*)(ws + WS_BIG + BIG_VT);
    float* ETb = (float*)(ws + WS_ET);
    bf16_t* Rb = (bf16_t*)(ws + WS_R); bf16_t* Obb = (bf16_t*)(ws + WS_OB);
    bf16_t* Dpb = (bf16_t*)(ws + WS_OB);
    bf16_t* Db = (bf16_t*)(ws + WS_R);

#ifndef NO_ADA
    ada_phase(lds, P);
#endif
    GSYNC();
#pragma unroll 1
    for (int layer = 0; layer < 4; ++layer) {
        const int kind = layer & 1, j = layer >> 1; const bool last = layer == 3;
        const float* modl = mod + (size_t)layer * NCOND * NADA;
        const float* src_lat = layer == 0 ? P.in[I_X] : Xl; const float* src_ctx = layer == 0 ? P.in[I_CTX] : Xc;
        const int Mall = TT, Mres = last ? TL : TT;
        unsigned char* wb = ws + ((layer & 1) ? WS_W2 : 0);
        bf16_t* Win_t = (bf16_t*)(wb + WS_WIN); bf16_t* Wout_t = (bf16_t*)(wb + WS_WOUT); bf16_t* Wf1_t = (bf16_t*)(wb + WS_WF1); bf16_t* Wf2_t = (bf16_t*)(wb + WS_WF2);
#ifndef NO_PREP
        prep_layer(lds, P, layer, 0, G);
#endif
        norm_mod_phase(src_lat, src_ctx, layer == 0 ? (const bf16_t*)nullptr : Db, Dpb, layer == 0 ? (float*)nullptr : Xl, Xc, P.in[I_N1G] + layer * DM, modl, 0, 1024, HZ, Mall);
        GSYNC();
        if (kind == 1) {
            pg8::Gemm g{HZ, Win_t, Mall, 3072, 1024}; pg8::StaticOrder S; S.init(Mall, 3072, 1024, G, bx);
            EpiGla E{QDf, KIf, QDb, KIb, Rb, ETb, P.in[I_GBR] + j * 1024, P.in[I_GBA] + j * 1024};
#ifndef NO_GGLA
            pg8::gemm_phase<EpiGla>(lds, g, S, E);
#endif
        }
        if (kind == 0) {
            pg8::Gemm g{HZ, Win_t, Mall, 3072, 1024}; pg8::StaticOrder S; S.init(Mall, 3072, 1024, G, bx);
            EpiConvIn E{BIG};
#ifndef NO_GPLAIN
            pg8::gemm_phase<EpiConvIn>(lds, g, S, E);
#endif
        } else {
            pg8::Gemm g{Win_t + (size_t)3072 * 1024, HZ, 1024, Mall, 1024}; pg8::StaticOrder S; S.init(1024, Mall, 1024, G, (bx + 64) % G);
            EpiPlain E{VTb, (size_t)TT};
#ifndef NO_GPLAIN
            pg8::gemm_phase<EpiPlain>(lds, g, S, E);
#endif
        }
        GSYNC();
        const bf16_t* Aout;
        if (kind == 0) {
            conv_phase(BIG, P.in[I_CW] + j * 3 * 1024, HZ, Mres);
            Aout = HZ;
        } else {
#ifndef NO_SCAN
            gla_scan_phase(lds, QDf, KIf, QDb, KIb, ETb, VTb, HZ, Obb);
#endif
            GSYNC();
            gla_out_phase(HZ, Obb, Rb, P.in[I_GNG] + j * 256, BIG, Mres);
            Aout = BIG;
        }
        GSYNC();
        {
            pg8::Gemm g{Aout, Wout_t, Mres, 1024, 1024};
            EpiDelta E{Db, modl + 2048, Dpb, last ? 0 : 1};
#ifndef NO_GRES
            if (last) { pg8::StaticOrder S; S.init(Mres, 1024, 1024, G, bx); pg8::gemm_phase<EpiDelta>(lds, g, S, E); }
            else { pg8::TailOrder S; S.init(1024, 1024, G, bx); pg8::gemm_phase<EpiDelta, pg8::TailOrder>(lds, g, S, E); }
#endif
        }
        GSYNC();
        norm_mod_phase(src_lat, src_ctx, Db, last ? (const bf16_t*)nullptr : Dpb, Xl, Xc, P.in[I_N2G] + layer * DM, modl, 3072, 4096, HZ, Mres);
        GSYNC();
        {
            pg8::Gemm g{HZ, Wf1_t, Mres, 5632, 1024}; pg8::StaticOrder S; S.init(Mres, 5632, 1024, G, bx);
            EpiSwiglu E{BIG};
#ifndef NO_GSWI
            pg8::gemm_phase<EpiSwiglu>(lds, g, S, E);
#endif
        }
        GSYNC();
        {
            pg8::Gemm g{BIG, Wf2_t, Mres, 1024, 2816};
            EpiDelta E{Db, modl + 5120, Dpb, last ? 0 : 1};
#ifndef NO_GRES
            if (last) { pg8::StaticOrder S; S.init(Mres, 1024, 2816, G, bx); pg8::gemm_phase<EpiDelta>(lds, g, S, E); }
            else { pg8::TailOrder S; S.init(1024, 2816, G, bx); pg8::gemm_phase<EpiDelta, pg8::TailOrder>(lds, g, S, E); }
#endif
        }
        GSYNC();
    }
    final_norm_phase(Xl, Db, P.in[I_FG], P.out);
}

extern "C" void kernel_launch(void* const* d_in, const int* in_sizes, int n_in, void* d_out, int out_size, void* d_ws, size_t ws_size, hipStream_t stream) {
    static int grid_blocks = 0;
    if (grid_blocks == 0) {
        if (n_in != 21 || ws_size < WS_END) { fprintf(stderr, "kernel_launch: unexpected n_in %d / ws_size %zu (need %zu)\n", n_in, ws_size, (size_t)WS_END); grid_blocks = -1; return; }
        int dev = 0, cus = 0, per_cu = 0;
        hipGetDevice(&dev);
        hipDeviceGetAttribute(&cus, hipDeviceAttributeMultiprocessorCount, dev);
        if (hipFuncSetAttribute((const void*)fwd_megakernel, hipFuncAttributeMaxDynamicSharedMemorySize, LDS_BYTES) != hipSuccess) { fprintf(stderr, "kernel_launch: hipFuncSetAttribute failed\n"); grid_blocks = -1; return; }
        if (hipOccupancyMaxActiveBlocksPerMultiprocessor(&per_cu, (const void*)fwd_megakernel, 512, LDS_BYTES) != hipSuccess || per_cu < 1) { fprintf(stderr, "kernel_launch: occupancy query says %d\n", per_cu); per_cu = 1; }
        (void)hipGetLastError();
        grid_blocks = cus;
    }
    if (grid_blocks < 0) return;
    if (hipMemsetAsync((char*)d_ws + WS_CTL, 0, XCD_BAR_WORDS * 4, stream) != hipSuccess) { fprintf(stderr, "kernel_launch: memset of the barrier words failed\n"); return; }
    Params p{};
    for (int i = 0; i < 21; ++i) p.in[i] = (const float*)d_in[i];
    p.out = (float*)d_out; p.ws = (unsigned char*)d_ws;
    void* args[] = {&p};
    hipError_t e = hipLaunchCooperativeKernel((const void*)fwd_megakernel, dim3(grid_blocks), dim3(512), args, LDS_BYTES, stream);
    if (e != hipSuccess) fprintf(stderr, "cooperative launch failed: %s (grid %d)\n", hipGetErrorString(e), grid_blocks);
}
```

```cpp
#include <hip/hip_runtime.h>
#include <hip/hip_cooperative_groups.h>
#include <cstdio>
#include <cstdint>
namespace cg = cooperative_groups;

#define LAS __attribute__((address_space(3)))
typedef unsigned short bf16_t;
typedef short bf16x8 __attribute__((ext_vector_type(8)));
typedef float f32x4 __attribute__((ext_vector_type(4)));
typedef float f32x2 __attribute__((ext_vector_type(2)));
typedef unsigned u32x4 __attribute__((ext_vector_type(4)));
typedef unsigned u32x2 __attribute__((ext_vector_type(2)));

constexpr int DM = 1024, TL = 32768, TC = 4096, TT = TL + TC, DFF = 2816, NCOND = 17, NADA = 6144;
constexpr int LDS_BYTES = 147456;
constexpr size_t MiB = 1u << 20;
constexpr size_t WS_WIN = 0, WS_WOUT = 8 * MiB, WS_WF1 = 10 * MiB, WS_WF2 = 21 * MiB, WS_MOD = 27 * MiB, WS_XCTX = 29 * MiB,
                 WS_HZ = 45 * MiB, WS_BIG = 117 * MiB, WS_R = 333 * MiB, WS_OB = 405 * MiB, WS_W2 = 477 * MiB  , WS_CTL = 504 * MiB, WS_ET = 505 * MiB  , WS_END = 508 * MiB;
constexpr size_t BIG_Q = 0, BIG_K = 36 * MiB, BIG_LA = 72 * MiB, BIG_VT = 144 * MiB;

struct Params { const float* in[21]; float* out; unsigned char* ws; };
enum { I_X = 0, I_C, I_CTX, I_CCTX, I_ADAW, I_ADAB, I_N1G, I_N2G, I_CWIN, I_CW, I_CWOUT, I_GWIN, I_GBR, I_GA1, I_GA2, I_GBA, I_GNG, I_GWOUT, I_FWIN, I_FWOUT, I_FG };

typedef __bf16 bf16x2v __attribute__((ext_vector_type(2)));
__device__ __forceinline__ unsigned cvt_pk_bf16(float lo, float hi) { f32x2 v = {lo, hi}; bf16x2v b = __builtin_convertvector(v, bf16x2v); return __builtin_bit_cast(unsigned, b); }
__device__ __forceinline__ float bf2f(unsigned short b) { return __uint_as_float(((unsigned)b) << 16); }
__device__ __forceinline__ unsigned short f2bf(float f) { return (unsigned short)(cvt_pk_bf16(f, 0.f) & 0xffffu); }
__device__ __forceinline__ float silu_f(float v) { return v * __builtin_amdgcn_rcpf(1.0f + __expf(-v)); }
__device__ __forceinline__ float wave_sum(float v) {
#pragma unroll
    for (int o = 1; o < 64; o <<= 1) v += __shfl_xor(v, o);
    return v;
}
__device__ __forceinline__ int opaque_tid() { int t = threadIdx.x; asm volatile("" : "+v"(t)); return t; }

__device__ __forceinline__ void grid_bar(unsigned* ctr, unsigned target) {
    asm volatile("s_waitcnt vmcnt(0) lgkmcnt(0)" ::: "memory");
    __syncthreads();
    if (threadIdx.x == 0) {
        __builtin_amdgcn_fence(__ATOMIC_RELEASE, "agent");
        asm volatile("s_waitcnt vmcnt(0)" ::: "memory");
        __hip_atomic_fetch_add(ctr, 1u, __ATOMIC_RELAXED, __HIP_MEMORY_SCOPE_AGENT);
        __builtin_amdgcn_fence(__ATOMIC_ACQUIRE, "agent");
        unsigned polls = 0; const unsigned long long t0 = __builtin_amdgcn_s_memrealtime();
        while ((int)(__hip_atomic_load(ctr, __ATOMIC_RELAXED, __HIP_MEMORY_SCOPE_AGENT) - target) < 0) {
            __builtin_amdgcn_s_sleep(1);
            if ((++polls & 255u) == 0u && __builtin_amdgcn_s_memrealtime() - t0 > 200000000ull) break;
        }
        asm volatile("s_waitcnt vmcnt(0)" ::: "memory");
    }
    __syncthreads();
}

#define XB_TMO      128
#define XB_XCNT(j)  (256  + 64 * (j))
#define XB_XSUB(j)  (1280 + 64 * (j))
#define XB_XGEN(j)  (2304 + 64 * (j))
#define XB_TOP      3328
#define XB_TOPGEN   3392
#define XCD_BAR_WORDS 3456
#define XB_SPIN_CAP (1u << 18)
__device__ __forceinline__ unsigned xb_ld(unsigned* p)              { return __hip_atomic_load(p, __ATOMIC_RELAXED, __HIP_MEMORY_SCOPE_AGENT); }
__device__ __forceinline__ unsigned xb_add(unsigned* p, unsigned v) { return __hip_atomic_fetch_add(p, v, __ATOMIC_RELAXED, __HIP_MEMORY_SCOPE_AGENT); }
__device__ __forceinline__ unsigned xb_xcc_id() { return (unsigned)__builtin_amdgcn_s_getreg((3 << 11) | 20) & 0xFu; }
#define XB_SPIN(cond, bar) do { unsigned _sp = 0; while (cond) { __builtin_amdgcn_s_sleep(1); \
    if ((++_sp & 255u) == 0u) { if (xb_ld(&(bar)[XB_TMO])) break; if (_sp > XB_SPIN_CAP) { atomicAdd(&(bar)[XB_TMO], 1u); break; } } } } while (0)
struct XcdBarrier { unsigned* bar; unsigned x; volatile LAS unsigned* st; };
__device__ __forceinline__ XcdBarrier xcd_barrier_post(unsigned* bar, volatile LAS unsigned* st) {
    XcdBarrier b; b.bar = bar; b.x = xb_xcc_id(); b.st = st;
    if (threadIdx.x == 0) (void)xb_add(&bar[XB_XCNT(b.x)], 1u);
    return b;
}
__device__ __forceinline__ void xcd_barrier_complete(unsigned* bar, unsigned x, unsigned& nloc, unsigned& nx) {
    const unsigned G = gridDim.x * gridDim.y * gridDim.z;
    unsigned sum, cnt, mine, sp = 0u;
    for (;;) {
        sum = 0u; cnt = 0u; mine = 0u;
#pragma unroll
        for (unsigned j = 0; j < 16; ++j) { const unsigned c = xb_ld(&bar[XB_XCNT(j)]); sum += c; cnt += (c > 0u) ? 1u : 0u; mine = (j == x) ? c : mine; }
        if (sum == G) break;
        __builtin_amdgcn_s_sleep(1);
        if ((++sp & 255u) == 0u) { if (xb_ld(&bar[XB_TMO])) break; if (sp > XB_SPIN_CAP) { atomicAdd(&bar[XB_TMO], 1u); break; } }
    }
    nloc = mine > 0u ? mine : 1u; nx = cnt > 0u ? cnt : 1u;
}
__device__ __forceinline__ void xcd_barrier(const XcdBarrier& b) {
    asm volatile("s_waitcnt vmcnt(0) lgkmcnt(0)" ::: "memory");
    __syncthreads();
    if (threadIdx.x == 0) {
        unsigned* bar = b.bar;
        __builtin_amdgcn_s_waitcnt(0);
        unsigned nloc = b.st[0], nx = b.st[1];
        if (nloc == 0u) { xcd_barrier_complete(bar, b.x, nloc, nx); b.st[0] = nloc; b.st[1] = nx; }
        const unsigned old = xb_add(&bar[XB_XSUB(b.x)], 1u);
        const unsigned gen = old / nloc;
        if (old + 1u == (gen + 1u) * nloc) {
            __builtin_amdgcn_fence(__ATOMIC_RELEASE, "agent");
            asm volatile("s_waitcnt vmcnt(0)" ::: "memory");
            const unsigned og = xb_add(&bar[XB_TOP], 1u);
            const unsigned tg = og / nx;
            __builtin_amdgcn_fence(__ATOMIC_ACQUIRE, "agent");
            if (og + 1u == (tg + 1u) * nx) xb_add(&bar[XB_TOPGEN], 1u);
            else XB_SPIN(xb_ld(&bar[XB_TOPGEN]) == tg, bar);
            xb_add(&bar[XB_XGEN(b.x)], 1u);
            asm volatile("s_waitcnt vmcnt(0)" ::: "memory");
        } else {
            __builtin_amdgcn_fence(__ATOMIC_ACQUIRE, "agent");
            XB_SPIN(xb_ld(&bar[XB_XGEN(b.x)]) == gen, bar);
            asm volatile("s_waitcnt vmcnt(0)" ::: "memory");
        }
    }
    __syncthreads();
}
#define LDS_WAIT() asm volatile("s_waitcnt lgkmcnt(0)" ::: "memory")

namespace pg8 {
constexpr int BM = 256, BK = 64, HALF = 128, HTB = HALF * BK * 2, STAGE_BYTES = 8 * HTB, NXCD = 8, WGM = 8;
__host__ __device__ __forceinline__ int lds_byte(int r, int c) { const int st = (r >> 4) * 2 + (c >> 5), rr = r & 15, cc = c & 31, ob = rr * 64 + cc * 2; return st * 1024 + (ob ^ (((ob >> 9) & 1) << 5)); }
__host__ __device__ __forceinline__ void stage_rc(int b, int& R, int& C) { const int st = b / 1024, sb = b % 1024, swz = sb ^ (((sb >> 9) & 1) << 5); R = (st >> 1) * 16 + swz / 64; C = (st & 1) * 32 + (swz % 64) / 2; }

__host__ __device__ __forceinline__ int perm32(int rho) { const int n = rho >> 4, i = rho & 15; return 8 * (i >> 2) + 4 * n + (i & 3); }
struct Unit { int pm, pn, k0, nt, part; };
struct Gemm { const bf16_t* A; const bf16_t* Bt; int M, N, K; };

struct StaticOrder {
    int nM, nN, nwg, G, c, ktiles;
    __host__ __device__ void init(int M, int N, int K, int G_, int c_) { nM = M / BM; nN = N / BM; nwg = nM * nN; G = G_; c = c_; ktiles = K / BK; }
    __host__ __device__ __forceinline__ int map(int L) const {
        int wgid = L; { const int q = nwg / NXCD, r = nwg % NXCD, xcd = wgid % NXCD, off = wgid / NXCD; wgid = (xcd < r ? xcd * (q + 1) : r * (q + 1) + (xcd - r) * q) + off; }
        const int nig = WGM * nN, gid = wgid / nig, fm = gid * WGM, gsz = (nM - fm) < WGM ? (nM - fm) : WGM;
        return ((fm + ((wgid % nig) % gsz)) << 16) | ((wgid % nig) / gsz);
    }
    __host__ __device__ __forceinline__ bool next(int i, Unit& u) const {
        const long L = (long)i * G + c; if (L >= nwg) return false;
        const int pp = map((int)L); Unit t; t.pm = pp >> 16; t.pn = pp & 0xffff; t.k0 = 0; t.nt = ktiles; t.part = 0; u = t; return true;
    }
};
struct TailOrder {
    StaticOrder lat; int q, r;
    __host__ __device__ void init(int N, int K, int G_, int c_) { lat.init(TL, N, K, G_, c_); const int kt = K / BK; q = (kt / 4) & ~1; r = kt - 4 * q; }
    __host__ __device__ __forceinline__ bool next(int i, Unit& u) const {
        const long L = (long)i * lat.G + lat.c;
        const int s = (int)(L - lat.nwg); if (s >= 64 * 4) return false;
        const bool whole = L < lat.nwg;
        const int pp = lat.map(whole ? (int)L : 0);
        const int part = s & 3, h2 = r >> 1;
        Unit t;
        t.pm = whole ? (pp >> 16) : TL / BM + (s >> 4); t.pn = whole ? (pp & 0xffff) : ((s >> 2) & 3);
        t.k0 = whole ? 0 : part * q + 2 * (part < h2 ? part : h2); t.nt = whole ? lat.ktiles : q + (part < h2 ? 2 : 0); t.part = whole ? 0 : part;
        u = t; return true;
    }
};

template <class Epi, class Sched = StaticOrder, bool ALIGN_EPI = true>
__device__ __forceinline__ void gemm_phase(LAS unsigned char* lds, const Gemm g, const Sched& S, const Epi& E) {
    const int tid = opaque_tid(), wid = __builtin_amdgcn_readfirstlane(tid >> 6), lane = tid & 63, wr = wid >> 2, wc = wid & 3, fr = lane & 15, fq = lane >> 4;
    const int K = g.K;
    unsigned voffA[2], voffB[2];
#pragma unroll
    for (int i = 0; i < 2; ++i) { int R, C; stage_rc(tid * 16 + i * 8192, R, C); const int Rb = (R & ~31) + perm32(R & 31); voffA[i] = (unsigned)(R * K + C) * 2u; voffB[i] = (unsigned)(Rb * K + C) * 2u; }
    const size_t kstep = (size_t)(BK * 2);
    const size_t hstep = (size_t)HALF * K * 2;
    const size_t tstep = 2 * hstep;
    const unsigned ldsw = (unsigned)wid * 1024u;
    const int aoff = lds_byte(wr * 64 + fr, fq * 8), boff = lds_byte(wc * 32 + fr, fq * 8);
#define PG8_SA(b, h) (((b) * 2 + (h)) * HTB)
#define PG8_SB(b, h) ((4 + (b) * 2 + (h)) * HTB)
#define PG8_STAGE(bufoff, gbase, voff) do { _Pragma("unroll") for (int _i = 0; _i < 2; ++_i) \
        __builtin_amdgcn_global_load_lds((const unsigned*)((const char*)(gbase) + (voff)[_i]), (LAS unsigned*)(lds + (bufoff) + ldsw + _i * 8192), 16, 0, 0); } while (0)
#define PG8_LDA(dst, b, h) do { _Pragma("unroll") for (int m = 0; m < 4; ++m) _Pragma("unroll") for (int k = 0; k < 2; ++k) dst[m][k] = *(const LAS bf16x8*)(lds + PG8_SA(b, h) + aoff + m * 2048 + k * 1024); } while (0)
#define PG8_LDB(dst, b, h) do { _Pragma("unroll") for (int n = 0; n < 2; ++n) _Pragma("unroll") for (int k = 0; k < 2; ++k) dst[n][k] = *(const LAS bf16x8*)(lds + PG8_SB(b, h) + boff + n * 2048 + k * 1024); } while (0)
#define PG8_MMA(ai, bj, At, Bt) do { __builtin_amdgcn_s_setprio(1); _Pragma("unroll") for (int m = 0; m < 4; ++m) _Pragma("unroll") for (int n = 0; n < 2; ++n) _Pragma("unroll") for (int k = 0; k < 2; ++k) \
        acc[ai][bj][m][n] = __builtin_amdgcn_mfma_f32_16x16x32_bf16(Bt[n][k], At[m][k], acc[ai][bj][m][n], 0, 0, 0); __builtin_amdgcn_s_setprio(0); } while (0)
#define PG8_WAIT_V(n) asm volatile("s_waitcnt vmcnt(" #n ")" ::: "memory")
#define PG8_WAIT_L(n) asm volatile("s_waitcnt lgkmcnt(" #n ")" ::: "memory")
#define PG8_BAR __builtin_amdgcn_s_barrier()
#define PG8_SCHED __builtin_amdgcn_sched_barrier(0)
    Unit cur, nxt; int ui = 0;
    if (!S.next(0, cur)) return;
    f32x4 acc[2][2][4][2];
#pragma unroll
    for (int a = 0; a < 2; ++a)
#pragma unroll
        for (int b = 0; b < 2; ++b)
#pragma unroll
            for (int m = 0; m < 4; ++m)
#pragma unroll
                for (int n = 0; n < 2; ++n) acc[a][b][m][n] = (f32x4){0.f, 0.f, 0.f, 0.f};
    bf16x8 At[4][2], B0[2][2], B1[2][2];
    const char* cA = (const char*)g.A + (size_t)cur.pm * tstep + (size_t)cur.k0 * kstep; const char* cB = (const char*)g.Bt + (size_t)cur.pn * tstep + (size_t)cur.k0 * kstep;
    PG8_STAGE(PG8_SB(0, 0), cB, voffB); PG8_STAGE(PG8_SB(0, 1), cB + hstep, voffB); PG8_STAGE(PG8_SA(0, 0), cA, voffA); PG8_STAGE(PG8_SA(0, 1), cA + hstep, voffA);
    if (wr == 1) PG8_BAR;
    PG8_WAIT_V(2); PG8_BAR;
    PG8_STAGE(PG8_SB(1, 0), cB + kstep, voffB); PG8_STAGE(PG8_SA(1, 0), cA + kstep, voffA); PG8_STAGE(PG8_SB(1, 1), cB + hstep + kstep, voffB);
    PG8_WAIT_V(6); PG8_BAR;
    for (;;) {
        const bool has_next = S.next(ui + 1, nxt);
        const char* nA = has_next ? (const char*)g.A + (size_t)nxt.pm * tstep + (size_t)nxt.k0 * kstep : cA; const char* nB = has_next ? (const char*)g.Bt + (size_t)nxt.pn * tstep + (size_t)nxt.k0 * kstep : cB;
        const int nt = cur.nt;
        for (int t = 0; t < nt; t += 2) {
            const bool last = (t == nt - 2);
            const char* a1 = cA + (size_t)(t + 1) * kstep;
            const char* a2 = last ? nA : cA + (size_t)(t + 2) * kstep; const char* b2 = last ? nB : cB + (size_t)(t + 2) * kstep;
            const char* a3 = a2 + kstep; const char* b3 = b2 + kstep;
            PG8_LDB(B0, 0, 0); PG8_LDB(B1, 0, 1); PG8_SCHED; PG8_LDA(At, 0, 0); PG8_STAGE(PG8_SA(1, 1), a1 + hstep, voffA);
            PG8_WAIT_V(8); PG8_WAIT_L(0); PG8_BAR; PG8_MMA(0, 0, At, B0); PG8_MMA(0, 1, At, B1); PG8_BAR; PG8_SCHED;
            PG8_LDA(At, 0, 1); PG8_STAGE(PG8_SB(0, 0), b2, voffB); PG8_STAGE(PG8_SB(0, 1), b2 + hstep, voffB); PG8_STAGE(PG8_SA(0, 0), a2, voffA);
            PG8_WAIT_V(8); PG8_WAIT_L(0); PG8_BAR; PG8_MMA(1, 0, At, B0); PG8_MMA(1, 1, At, B1); PG8_BAR; PG8_SCHED;
            PG8_LDB(B0, 1, 0); PG8_LDB(B1, 1, 1); PG8_SCHED; PG8_LDA(At, 1, 0); PG8_STAGE(PG8_SA(0, 1), a2 + hstep, voffA);
            PG8_WAIT_V(8); PG8_WAIT_L(0); PG8_BAR; PG8_MMA(0, 0, At, B0); PG8_MMA(0, 1, At, B1); PG8_BAR; PG8_SCHED;
            PG8_LDA(At, 1, 1); PG8_STAGE(PG8_SB(1, 0), b3, voffB); PG8_STAGE(PG8_SB(1, 1), b3 + hstep, voffB); PG8_STAGE(PG8_SA(1, 0), a3, voffA);
            PG8_WAIT_V(8); PG8_WAIT_L(0); PG8_BAR; PG8_MMA(1, 0, At, B0); PG8_MMA(1, 1, At, B1); PG8_BAR; PG8_SCHED;
        }
        if constexpr (ALIGN_EPI) { if (wr == 0) PG8_BAR; }
        E(acc, cur, wr, wc, fr, fq);
        if (!has_next) break;
#pragma unroll
        for (int a = 0; a < 2; ++a)
#pragma unroll
            for (int b = 0; b < 2; ++b)
#pragma unroll
                for (int m = 0; m < 4; ++m)
#pragma unroll
                    for (int n = 0; n < 2; ++n) acc[a][b][m][n] = (f32x4){0.f, 0.f, 0.f, 0.f};
        cur = nxt; cA = nA; cB = nB; ++ui;
        if constexpr (ALIGN_EPI) { if (wr == 1) PG8_BAR; }
    }
    PG8_WAIT_V(0);
    if constexpr (!ALIGN_EPI) { if (wr == 0) PG8_BAR; }
    PG8_BAR;
#undef PG8_SA
#undef PG8_SB
#undef PG8_STAGE
#undef PG8_LDA
#undef PG8_LDB
#undef PG8_MMA
#undef PG8_WAIT_V
#undef PG8_WAIT_L
#undef PG8_BAR
#undef PG8_SCHED
}
}
using pg8::Unit;
typedef f32x4 AccT[2][2][4][2];

#define PACK8(v0, v1) (u32x4){cvt_pk_bf16((v0)[0], (v0)[1]), cvt_pk_bf16((v0)[2], (v0)[3]), cvt_pk_bf16((v1)[0], (v1)[1]), cvt_pk_bf16((v1)[2], (v1)[3])}
struct EpiPlain {
    bf16_t* O; size_t ldc;
    __device__ __forceinline__ void operator()(const AccT& acc, const Unit& u, int wr, int wc, int fr, int fq) const {
        const int row0 = u.pm * 256 + wr * 64 + fr, col0 = u.pn * 256 + wc * 32 + 8 * fq;
#pragma unroll
        for (int ai = 0; ai < 2; ++ai)
#pragma unroll
            for (int m = 0; m < 4; ++m) { bf16_t* rowp = O + (size_t)(row0 + ai * 128 + m * 16) * ldc + col0;
#pragma unroll
                for (int bj = 0; bj < 2; ++bj) *(u32x4*)(rowp + bj * 128) = PACK8(acc[ai][bj][m][0], acc[ai][bj][m][1]); }
    }
};
struct EpiGla {
    bf16_t *QDf, *KIf, *QDb, *KIb, *R; float* ET; const float *b_r, *b_a;
    __device__ __forceinline__ void operator()(const AccT& acc, const Unit& u, int wr, int wc, int fr, int fq) const {
        const int row0 = u.pm * 256 + wr * 64 + fr;
        const int pn = u.pn;
        if (pn < 8) {
            const int d0 = 64 * pn + 16 * wc + 4 * fq;
            const f32x4 baf = *(const f32x4*)(b_a + d0), bab = *(const f32x4*)(b_a + 512 + d0);
#pragma unroll
            for (int ai = 0; ai < 2; ++ai) {
                f32x4 pf[4], pb[4];
#pragma unroll
                for (int m = 0; m < 4; ++m) {
                    const f32x4 xf = acc[ai][1][m][0] + baf, xb = acc[ai][1][m][1] + bab;
#pragma unroll
                    for (int j = 0; j < 4; ++j) { pf[m][j] = (fminf(xf[j], 0.f) - __logf(1.0f + __expf(-fabsf(xf[j])))) * 0.0625f; pb[m][j] = (fminf(xb[j], 0.f) - __logf(1.0f + __expf(-fabsf(xb[j])))) * 0.0625f; }
                }
                f32x4 lb[4];
#pragma unroll
                for (int m = 0; m < 4; ++m) lb[m] = pb[m];
#pragma unroll
                for (int dl = 1; dl < 16; dl <<= 1) {
#pragma unroll
                    for (int m = 0; m < 4; ++m)
#pragma unroll
                        for (int j = 0; j < 4; ++j) { const float tf = __shfl_up(pf[m][j], dl, 16), tb = __shfl_up(pb[m][j], dl, 16); if (fr >= dl) { pf[m][j] += tf; pb[m][j] += tb; } }
                }
                f32x4 of = (f32x4){0.f, 0.f, 0.f, 0.f}, ob = of;
#pragma unroll
                for (int m = 0; m < 4; ++m)
#pragma unroll
                    for (int j = 0; j < 4; ++j) { const float tf = __shfl(pf[m][j], 15, 16), tb = __shfl(pb[m][j], 15, 16); pf[m][j] += of[j]; pb[m][j] += ob[j]; of[j] += tf; ob[j] += tb; }
                const int rbase = row0 + ai * 128;
                if (fr == 0) { const int chunk = (u.pm * 256 + ai * 128 + wr * 64) >> 6; f32x4 e0, e1;
#pragma unroll
                    for (int j = 0; j < 4; ++j) { e0[j] = __expf(of[j]); e1[j] = __expf(ob[j]); }
                    *(f32x4*)(ET + ((size_t)chunk * 2 + 0) * 512 + d0) = e0; *(f32x4*)(ET + ((size_t)chunk * 2 + 1) * 512 + d0) = e1; }
#pragma unroll
                for (int m = 0; m < 4; ++m) {
                    const f32x4 q = acc[ai][0][m][0] * 0.08838834764831845f, k = acc[ai][0][m][1];
                    f32x4 qf, kf, qb, kb;
#pragma unroll
                    for (int j = 0; j < 4; ++j) { const float bfw = pf[m][j], bbw = ob[j] - pb[m][j] + lb[m][j];
                        const float ef = __expf(bfw), eb = __expf(bbw);
                        qf[j] = q[j] * ef; kf[j] = k[j] * __builtin_amdgcn_rcpf(ef); qb[j] = q[j] * eb; kb[j] = k[j] * __builtin_amdgcn_rcpf(eb); }
                    const size_t off = (size_t)(rbase + m * 16) * 512 + d0;
                    u32x2 w;
                    w.x = cvt_pk_bf16(qf[0], qf[1]); w.y = cvt_pk_bf16(qf[2], qf[3]); *(u32x2*)(QDf + off) = w;
                    w.x = cvt_pk_bf16(kf[0], kf[1]); w.y = cvt_pk_bf16(kf[2], kf[3]); *(u32x2*)(KIf + off) = w;
                    w.x = cvt_pk_bf16(qb[0], qb[1]); w.y = cvt_pk_bf16(qb[2], qb[3]); *(u32x2*)(QDb + off) = w;
                    w.x = cvt_pk_bf16(kb[0], kb[1]); w.y = cvt_pk_bf16(kb[2], kb[3]); *(u32x2*)(KIb + off) = w;
                }
            }
        } else {
            const int col0 = (pn - 8) * 256 + wc * 32 + 8 * fq;
            f32x4 bv[2][2];
#pragma unroll
            for (int bj = 0; bj < 2; ++bj)
#pragma unroll
                for (int n = 0; n < 2; ++n) bv[bj][n] = *(const f32x4*)(b_r + col0 + bj * 128 + n * 4);
#pragma unroll
            for (int ai = 0; ai < 2; ++ai)
#pragma unroll
                for (int m = 0; m < 4; ++m) { bf16_t* rowp = R + (size_t)(row0 + ai * 128 + m * 16) * 1024 + col0;
#pragma unroll
                    for (int bj = 0; bj < 2; ++bj) { f32x4 v0 = acc[ai][bj][m][0] + bv[bj][0], v1 = acc[ai][bj][m][1] + bv[bj][1];
#pragma unroll
                        for (int j = 0; j < 4; ++j) { v0[j] = silu_f(v0[j]); v1[j] = silu_f(v1[j]); }
                        *(u32x4*)(rowp + bj * 128) = PACK8(v0, v1); } }
        }
    }
};
struct EpiDelta {
    bf16_t* D; const float* gate; bf16_t* Dp; int split;
    __device__ __forceinline__ void operator()(const AccT& acc, const Unit& u, int wr, int wc, int fr, int fq) const {
        const int rt = u.pm * 256; const int b = rt >= TL ? 16 : (rt >> 11);
        const int colt = u.pn * 256 + wc * 32 + 8 * fq;
        const float* gp = gate + (size_t)b * NADA + colt;
        f32x4 gv[2][2];
#pragma unroll
        for (int bj = 0; bj < 2; ++bj)
#pragma unroll
            for (int n = 0; n < 2; ++n) gv[bj][n] = *(const f32x4*)(gp + bj * 128 + n * 4);
#pragma unroll
        for (int ai = 0; ai < 2; ++ai)
#pragma unroll
            for (int m = 0; m < 4; ++m) { bf16_t* rowp = (split && rt >= TL ? Dp + (size_t)u.part * TC * DM + (size_t)(rt - TL + wr * 64 + fr + ai * 128 + m * 16) * DM : D + (size_t)(rt + wr * 64 + fr + ai * 128 + m * 16) * DM) + colt;
#pragma unroll
                for (int bj = 0; bj < 2; ++bj) { const f32x4 v0 = gv[bj][0] * acc[ai][bj][m][0], v1 = gv[bj][1] * acc[ai][bj][m][1]; *(u32x4*)(rowp + bj * 128) = PACK8(v0, v1); } }
    }
};
struct EpiConvIn {
    bf16_t* PU;
    __device__ __forceinline__ void operator()(const AccT& acc, const Unit& u, int wr, int wc, int fr, int fq) const {
        const int row0 = u.pm * 256 + wr * 64 + fr;
        if (u.pn < 4) {
            const int col0 = u.pn * 256 + wc * 32 + 8 * fq;
#pragma unroll
            for (int ai = 0; ai < 2; ++ai)
#pragma unroll
                for (int m = 0; m < 4; ++m) { bf16_t* rowp = PU + (size_t)(row0 + ai * 128 + m * 16) * 2048 + col0;
#pragma unroll
                    for (int bj = 0; bj < 2; ++bj) *(u32x4*)(rowp + bj * 128) = PACK8(acc[ai][bj][m][0], acc[ai][bj][m][1]); }
        } else {
            const int col0 = 1024 + (u.pn - 4) * 128 + wc * 32 + 8 * fq;
#pragma unroll
            for (int ai = 0; ai < 2; ++ai)
#pragma unroll
                for (int m = 0; m < 4; ++m) { bf16_t* rowp = PU + (size_t)(row0 + ai * 128 + m * 16) * 2048 + col0;
                    const f32x4 v0 = acc[ai][0][m][0] * acc[ai][1][m][0], v1 = acc[ai][0][m][1] * acc[ai][1][m][1];
                    *(u32x4*)(rowp) = PACK8(v0, v1); }
        }
    }
};
struct EpiSwiglu {
    bf16_t* F;
    __device__ __forceinline__ void operator()(const AccT& acc, const Unit& u, int wr, int wc, int fr, int fq) const {
        const int row0 = u.pm * 256 + wr * 64 + fr, col0 = u.pn * 128 + wc * 32 + 8 * fq;
#pragma unroll
        for (int ai = 0; ai < 2; ++ai)
#pragma unroll
            for (int m = 0; m < 4; ++m) { bf16_t* rowp = F + (size_t)(row0 + ai * 128 + m * 16) * DFF + col0;
                f32x4 v0, v1;
#pragma unroll
                for (int j = 0; j < 4; ++j) { v0[j] = silu_f(acc[ai][0][m][0][j]) * acc[ai][1][m][0][j]; v1[j] = silu_f(acc[ai][0][m][1][j]) * acc[ai][1][m][1][j]; }
                *(u32x4*)(rowp) = PACK8(v0, v1); }
    }
};

__device__ __forceinline__ void ada_phase(LAS unsigned char* lds, const Params& P) {
    LAS float* sc = (LAS float*)lds;
    LAS float* red = sc + NCOND * 1024;
    const int tid = opaque_tid(), wave = tid >> 6, lane = tid & 63;
    const float* c = P.in[I_C]; const float* cctx = P.in[I_CCTX]; const float* adaw = P.in[I_ADAW]; const float* adab = P.in[I_ADAB];
    float* mod = (float*)(P.ws + WS_MOD);
    if ((int)blockIdx.x >= 192) return;
    for (int idx = tid; idx < NCOND * 1024; idx += 512) { const int b = idx >> 10, k = idx & 1023; const float v = b < 16 ? c[b * 1024 + k] : cctx[k]; sc[idx] = silu_f(v); }
    __syncthreads();
    for (int item = blockIdx.x; item < 192; item += gridDim.x) {
        const int l = item / 48, n0 = (item % 48) * 128;
        float acc[NCOND][2];
#pragma unroll
        for (int b = 0; b < NCOND; ++b) { acc[b][0] = 0.f; acc[b][1] = 0.f; }
        const float* wbase = adaw + ((size_t)l * 1024) * NADA + n0 + 2 * lane;
        for (int k = 128 * wave; k < 128 * wave + 128; k += 16) {
            f32x2 wv[16];
#pragma unroll
            for (int i = 0; i < 16; ++i) wv[i] = __builtin_nontemporal_load((const f32x2*)(wbase + (size_t)(k + i) * NADA));
#pragma unroll
            for (int b = 0; b < NCOND; ++b) {
#pragma unroll
                for (int kk = 0; kk < 16; kk += 4) { const f32x4 s4 = *(const LAS f32x4*)(sc + b * 1024 + k + kk);
                    acc[b][0] += s4[0] * wv[kk][0] + s4[1] * wv[kk + 1][0] + s4[2] * wv[kk + 2][0] + s4[3] * wv[kk + 3][0];
                    acc[b][1] += s4[0] * wv[kk][1] + s4[1] * wv[kk + 1][1] + s4[2] * wv[kk + 2][1] + s4[3] * wv[kk + 3][1]; } }
        }
#pragma unroll
        for (int b = 0; b < NCOND; ++b) { red[(wave * NCOND + b) * 128 + 2 * lane] = acc[b][0]; red[(wave * NCOND + b) * 128 + 2 * lane + 1] = acc[b][1]; }
        __syncthreads();
        for (int idx = tid; idx < NCOND * 128; idx += 512) { const int b = idx >> 7, cc = idx & 127; float s = 0.f;
#pragma unroll
            for (int w = 0; w < 8; ++w) s += red[(w * NCOND + b) * 128 + cc];
            mod[((size_t)l * NCOND + b) * NADA + n0 + cc] = s + adab[l * NADA + n0 + cc]; }
        __syncthreads();
    }
}

__host__ __device__ __forceinline__ int qkl_row(int type, int d) { return 256 * (d >> 6) + 128 * (type >> 1) + 32 * ((d >> 4) & 3) + 8 * ((d >> 2) & 3) + 4 * (type & 1) + (d & 3); }
__device__ __forceinline__ void transpose_item(const float* W, int K, int N, bf16_t* WT, int wt_row0, int k0, int n0, LAS float* scr, int lane, int qkl_type = -1) {
#pragma unroll 8
    for (int i = 0; i < 32; ++i) { const int kk = 2 * i + (lane >> 5); scr[kk * 33 + (lane & 31)] = __builtin_nontemporal_load(W + (size_t)(k0 + kk) * N + n0 + (lane & 31)); }
    LDS_WAIT(); asm volatile("" ::: "memory");
    const int c = lane & 7;
#pragma unroll
    for (int j = 0; j < 4; ++j) { const int n = (lane >> 3) + 8 * j; const LAS float* s = scr + (8 * c) * 33 + n;
        u32x4 o; o.x = cvt_pk_bf16(s[0 * 33], s[1 * 33]); o.y = cvt_pk_bf16(s[2 * 33], s[3 * 33]); o.z = cvt_pk_bf16(s[4 * 33], s[5 * 33]); o.w = cvt_pk_bf16(s[6 * 33], s[7 * 33]);
        const int drow = qkl_type >= 0 ? qkl_row(qkl_type, wt_row0 + n) : wt_row0 + n;
        *(u32x4*)(WT + (size_t)drow * K + k0 + 8 * c) = o; }
    LDS_WAIT(); asm volatile("" ::: "memory");
}
__device__ __forceinline__ void prep_layer(LAS unsigned char* lds, const Params& P, int layer, int c0, int nblk) {
    const int tid = opaque_tid(), wave = tid >> 6, lane = tid & 63;
    const int kind = layer & 1, j = layer >> 1;
    LAS float* scr = (LAS float*)(lds + wave * 8704);
    unsigned char* wb = P.ws + ((layer & 1) ? WS_W2 : 0);
    bf16_t* Win_t = (bf16_t*)(wb + WS_WIN); bf16_t* Wout_t = (bf16_t*)(wb + WS_WOUT); bf16_t* Wf1_t = (bf16_t*)(wb + WS_WF1); bf16_t* Wf2_t = (bf16_t*)(wb + WS_WF2);
    const float* Win = (kind == 0 ? P.in[I_CWIN] : P.in[I_GWIN]) + (size_t)j * 1024 * 3072;
    const float* Wout = (kind == 0 ? P.in[I_CWOUT] : P.in[I_GWOUT]) + (size_t)j * 1024 * 1024;
    const float* Wf1 = P.in[I_FWIN] + (size_t)layer * 1024 * 5632;
    const float* Wf2 = P.in[I_FWOUT] + (size_t)layer * 2816 * 1024;
    const int gw = ((int)blockIdx.x - c0) * 8 + wave, NGW = nblk * 8;
    for (int it = gw; it < 6272; it += NGW) {
        if (it < 1536) { const int kb = it / 96, n0 = (it % 96) * 32;
            if (kind == 0) { const int row0 = n0 < 1024 ? n0 : (n0 < 2048 ? 1024 + 256 * ((n0 - 1024) / 128) + ((n0 - 1024) % 128) : 1024 + 256 * ((n0 - 2048) / 128) + 128 + ((n0 - 2048) % 128));
                transpose_item(Win, 1024, 3072, Win_t, row0, kb * 64, n0, scr, lane); }
            else if (n0 < 1024) transpose_item(Win, 1024, 3072, Win_t, n0 & 511, kb * 64, n0, scr, lane, n0 >> 9);
            else transpose_item(Win, 1024, 3072, Win_t, n0 < 2048 ? n0 + 2048 : n0, kb * 64, n0, scr, lane); }
        else if (it < 2048) { const int r = it - 1536; const int kb = r / 32, n0 = (r % 32) * 32; transpose_item(Wout, 1024, 1024, Wout_t, n0, kb * 64, n0, scr, lane); }
        else if (it < 4864) { const int r = it - 2048; const int kb = r / 176, n0 = (r % 176) * 32;
            const int row0 = n0 < 2816 ? 256 * (n0 / 128) + (n0 % 128) : 256 * ((n0 - 2816) / 128) + 128 + ((n0 - 2816) % 128);
            transpose_item(Wf1, 1024, 5632, Wf1_t, row0, kb * 64, n0, scr, lane); }
        else { const int r = it - 4864; const int kb = r / 32, n0 = (r % 32) * 32; transpose_item(Wf2, 2816, 1024, Wf2_t, n0, kb * 64, n0, scr, lane); }
    }
    if (kind == 1) {
        const float* a1 = P.in[I_GA1] + (size_t)j * 2 * 1024 * 16; const float* a2 = P.in[I_GA2] + (size_t)j * 2 * 16 * 512;
        const int gt = ((int)blockIdx.x - c0) * 512 + tid, NT = nblk * 512;
        for (int idx = gt; idx < 1024 * 128; idx += NT) {
            const int row = idx >> 7, kg = idx & 127, dir = row >> 9, d = row & 511;
            float a2v[16];
#pragma unroll
            for (int r = 0; r < 16; ++r) a2v[r] = a2[((size_t)dir * 16 + r) * 512 + d];
            float o[8];
#pragma unroll
            for (int kk = 0; kk < 8; ++kk) { const f32x4* ar = (const f32x4*)(a1 + ((size_t)dir * 1024 + 8 * kg + kk) * 16); float s = 0.f;
#pragma unroll
                for (int q = 0; q < 4; ++q) { const f32x4 av = ar[q]; s += av[0] * a2v[4 * q] + av[1] * a2v[4 * q + 1] + av[2] * a2v[4 * q + 2] + av[3] * a2v[4 * q + 3]; }
                o[kk] = s; }
            u32x4 w; w.x = cvt_pk_bf16(o[0], o[1]); w.y = cvt_pk_bf16(o[2], o[3]); w.z = cvt_pk_bf16(o[4], o[5]); w.w = cvt_pk_bf16(o[6], o[7]);
            *(u32x4*)(Win_t + (size_t)qkl_row(2 + dir, d) * 1024 + 8 * kg) = w;
        }
    }
}

__device__ __forceinline__ void norm_mod_phase(const float* src_lat, const float* src_ctx, const bf16_t* delta, const bf16_t* dparts, float* xo_lat, float* xo_ctx,
                                               const float* gain, const float* modl, int shoff, int scoff, bf16_t* H, int nrows) {
    const int tid = opaque_tid(), wave = tid >> 6, lane = tid & 63;
    const int gw = blockIdx.x * 8 + wave, NGW = gridDim.x * 8;
    for (int r0 = gw * 4; r0 < nrows; r0 += NGW * 4) {
        const float* xrow = r0 < TL ? src_lat + (size_t)r0 * DM : src_ctx + (size_t)(r0 - TL) * DM; const int b = r0 < TL ? (r0 >> 11) : 16;
        float* xout = r0 < TL ? xo_lat + (size_t)r0 * DM : xo_ctx + (size_t)(r0 - TL) * DM;
        f32x4 v[4][4]; float ss[4];
#pragma unroll
        for (int i = 0; i < 4; ++i)
#pragma unroll
            for (int q = 0; q < 4; ++q) v[i][q] = __builtin_nontemporal_load((const f32x4*)(xrow + (size_t)i * DM) + lane + 64 * q);
        if (delta) {
            const int np = (dparts && r0 >= TL) ? 4 : 1;
            for (int p = 0; p < np; ++p) {
                const bf16_t* dsrc = np == 4 ? dparts + (size_t)p * TC * DM + (size_t)(r0 - TL) * DM : delta + (size_t)r0 * DM;
                u32x2 dv[4][4];
#pragma unroll
                for (int i = 0; i < 4; ++i)
#pragma unroll
                    for (int q = 0; q < 4; ++q) dv[i][q] = __builtin_nontemporal_load((const u32x2*)(dsrc + (size_t)i * DM + 4 * lane + 256 * q));
#pragma unroll
                for (int i = 0; i < 4; ++i)
#pragma unroll
                    for (int q = 0; q < 4; ++q) { v[i][q][0] += bf2f((unsigned short)(dv[i][q].x & 0xffff)); v[i][q][1] += bf2f((unsigned short)(dv[i][q].x >> 16));
                        v[i][q][2] += bf2f((unsigned short)(dv[i][q].y & 0xffff)); v[i][q][3] += bf2f((unsigned short)(dv[i][q].y >> 16)); }
            }
        }
#pragma unroll
        for (int i = 0; i < 4; ++i)
#pragma unroll
            for (int q = 0; q < 4; ++q) { if (xo_lat) __builtin_nontemporal_store(v[i][q], (f32x4*)(xout + (size_t)i * DM) + lane + 64 * q); }
        const float* mb = modl + (size_t)b * NADA;
        f32x4 g4[4], sc4[4], sh4[4];
#pragma unroll
        for (int q = 0; q < 4; ++q) { const int col = 4 * lane + 256 * q; g4[q] = *(const f32x4*)(gain + col); sc4[q] = *(const f32x4*)(mb + scoff + col) + 1.0f; sh4[q] = *(const f32x4*)(mb + shoff + col); }
#pragma unroll
        for (int i = 0; i < 4; ++i) { float s = 0.f;
#pragma unroll
            for (int q = 0; q < 4; ++q) s += (v[i][q][0] * v[i][q][0] + v[i][q][1] * v[i][q][1]) + (v[i][q][2] * v[i][q][2] + v[i][q][3] * v[i][q][3]);
            ss[i] = s; }
#pragma unroll
        for (int o = 1; o < 64; o <<= 1) {
#pragma unroll
            for (int i = 0; i < 4; ++i) ss[i] += __shfl_xor(ss[i], o); }
#pragma unroll
        for (int i = 0; i < 4; ++i) { const float rstd = rsqrtf(ss[i] * (1.0f / DM) + 1e-6f);
#pragma unroll
            for (int q = 0; q < 4; ++q) { const int col = 4 * lane + 256 * q; const f32x4 h = (v[i][q] * rstd * g4[q]) * sc4[q] + sh4[q];
                u32x2 w; w.x = cvt_pk_bf16(h[0], h[1]); w.y = cvt_pk_bf16(h[2], h[3]); *(u32x2*)(H + (size_t)(r0 + i) * DM + col) = w; } }
    }
}
__device__ __forceinline__ void final_norm_phase(const float* X, const bf16_t* delta, const float* gain, float* out) {
    const int tid = opaque_tid(), wave = tid >> 6, lane = tid & 63;
    const int gw = blockIdx.x * 8 + wave, NGW = gridDim.x * 8;
    for (int r0 = gw * 4; r0 < TL; r0 += NGW * 4) {
        f32x4 v[4][4]; float ss[4]; u32x2 dv[4][4];
#pragma unroll
        for (int i = 0; i < 4; ++i)
#pragma unroll
            for (int q = 0; q < 4; ++q) { v[i][q] = __builtin_nontemporal_load((const f32x4*)(X + (size_t)(r0 + i) * DM) + lane + 64 * q); dv[i][q] = __builtin_nontemporal_load((const u32x2*)(delta + (size_t)(r0 + i) * DM + 4 * lane + 256 * q)); }
        f32x4 g4[4];
#pragma unroll
        for (int q = 0; q < 4; ++q) g4[q] = *(const f32x4*)(gain + 4 * lane + 256 * q);
#pragma unroll
        for (int i = 0; i < 4; ++i) { float s = 0.f;
#pragma unroll
            for (int q = 0; q < 4; ++q) { v[i][q][0] += bf2f((unsigned short)(dv[i][q].x & 0xffff)); v[i][q][1] += bf2f((unsigned short)(dv[i][q].x >> 16));
                v[i][q][2] += bf2f((unsigned short)(dv[i][q].y & 0xffff)); v[i][q][3] += bf2f((unsigned short)(dv[i][q].y >> 16));
                s += (v[i][q][0] * v[i][q][0] + v[i][q][1] * v[i][q][1]) + (v[i][q][2] * v[i][q][2] + v[i][q][3] * v[i][q][3]); }
            ss[i] = s; }
#pragma unroll
        for (int o = 1; o < 64; o <<= 1) {
#pragma unroll
            for (int i = 0; i < 4; ++i) ss[i] += __shfl_xor(ss[i], o); }
#pragma unroll
        for (int i = 0; i < 4; ++i) { const float rstd = rsqrtf(ss[i] * (1.0f / DM) + 1e-6f);
#pragma unroll
            for (int q = 0; q < 4; ++q) __builtin_nontemporal_store(v[i][q] * rstd * g4[q], (f32x4*)(out + (size_t)(r0 + i) * DM + 4 * lane + 256 * q)); }
    }
}
__device__ __forceinline__ void conv_phase(const bf16_t* PU, const float* cw, bf16_t* Z, int ntok) {
    const int gt = blockIdx.x * 512 + opaque_tid(), NT = gridDim.x * 512;
    const int total = (ntok >> 3) * 128;
    for (int idx = gt; idx < total; idx += NT) {
        const int t0 = (idx >> 7) * 8, cg8 = (idx & 127) * 8;
        int pos0, len; if (t0 < TL) { pos0 = t0 & 63; len = 64; } else { pos0 = (t0 - TL) & 255; len = 256; }
        const bf16_t* row = PU + (size_t)t0 * 2048 + cg8;
        const bool hasp = pos0 > 0, hasn = pos0 + 8 < len;
        u32x4 gbv[8], uv[10];
        const u32x4 z4 = (u32x4){0, 0, 0, 0};
        uv[0] = z4; uv[9] = z4;
        if (hasp) uv[0] = __builtin_nontemporal_load((const u32x4*)(row - 2048 + 1024));
#pragma unroll
        for (int i = 0; i < 8; ++i) { gbv[i] = __builtin_nontemporal_load((const u32x4*)(row + (size_t)i * 2048)); uv[i + 1] = __builtin_nontemporal_load((const u32x4*)(row + (size_t)i * 2048 + 1024)); }
        if (hasn) uv[9] = __builtin_nontemporal_load((const u32x4*)(row + (size_t)8 * 2048 + 1024));
        float w0[8], w1[8], w2[8];
#pragma unroll
        for (int e = 0; e < 8; ++e) { w0[e] = cw[cg8 + e]; w1[e] = cw[1024 + cg8 + e]; w2[e] = cw[2048 + cg8 + e]; }
#pragma unroll
        for (int i = 0; i < 8; ++i) {
            float o[8];
#pragma unroll
            for (int q = 0; q < 4; ++q) {
                const float gb0 = bf2f((unsigned short)(gbv[i][q] & 0xffff)), gb1 = bf2f((unsigned short)(gbv[i][q] >> 16));
                const float p0 = bf2f((unsigned short)(uv[i][q] & 0xffff)), p1 = bf2f((unsigned short)(uv[i][q] >> 16));
                const float c0 = bf2f((unsigned short)(uv[i + 1][q] & 0xffff)), c1 = bf2f((unsigned short)(uv[i + 1][q] >> 16));
                const float n0 = bf2f((unsigned short)(uv[i + 2][q] & 0xffff)), n1 = bf2f((unsigned short)(uv[i + 2][q] >> 16));
                o[2 * q] = gb0 * (w0[2 * q] * p0 + w1[2 * q] * c0 + w2[2 * q] * n0);
                o[2 * q + 1] = gb1 * (w0[2 * q + 1] * p1 + w1[2 * q + 1] * c1 + w2[2 * q + 1] * n1); }
            u32x4 w; w.x = cvt_pk_bf16(o[0], o[1]); w.y = cvt_pk_bf16(o[2], o[3]); w.z = cvt_pk_bf16(o[4], o[5]); w.w = cvt_pk_bf16(o[6], o[7]);
            *(u32x4*)(Z + (size_t)(t0 + i) * DM + cg8) = w;
        }
    }
}
__device__ __forceinline__ void gla_out_phase(const bf16_t* Of, const bf16_t* Ob, const bf16_t* R, const float* ng, bf16_t* G, int ntok) {
    const int tid = opaque_tid(), wave = tid >> 6, lane = tid & 63;
    const int gw = blockIdx.x * 8 + wave, NGW = gridDim.x * 8;
    const float* ngp = ng + ((16 * lane) & 255);
    float ngv[16];
#pragma unroll
    for (int e = 0; e < 16; ++e) ngv[e] = ngp[e];
    for (int t0 = gw * 2; t0 < ntok; t0 += NGW * 2) {
        u32x4 av[2][2], bv[2][2], rv[2][2];
#pragma unroll
        for (int i = 0; i < 2; ++i) { const size_t off = (size_t)(t0 + i) * DM + 16 * lane;
            av[i][0] = __builtin_nontemporal_load((const u32x4*)(Of + off)); av[i][1] = __builtin_nontemporal_load((const u32x4*)(Of + off + 8)); bv[i][0] = __builtin_nontemporal_load((const u32x4*)(Ob + off)); bv[i][1] = __builtin_nontemporal_load((const u32x4*)(Ob + off + 8));
            rv[i][0] = __builtin_nontemporal_load((const u32x4*)(R + off)); rv[i][1] = __builtin_nontemporal_load((const u32x4*)(R + off + 8)); }
#pragma unroll
        for (int i = 0; i < 2; ++i) {
            float o[16]; float s = 0.f;
#pragma unroll
            for (int hh = 0; hh < 2; ++hh)
#pragma unroll
                for (int q = 0; q < 4; ++q) {
                    o[8 * hh + 2 * q] = bf2f((unsigned short)(av[i][hh][q] & 0xffff)) + bf2f((unsigned short)(bv[i][hh][q] & 0xffff));
                    o[8 * hh + 2 * q + 1] = bf2f((unsigned short)(av[i][hh][q] >> 16)) + bf2f((unsigned short)(bv[i][hh][q] >> 16)); }
#pragma unroll
            for (int e = 0; e < 16; ++e) s += o[e] * o[e];
            s += __shfl_xor(s, 1); s += __shfl_xor(s, 2); s += __shfl_xor(s, 4); s += __shfl_xor(s, 8);
            const float rstd = rsqrtf(s * (1.0f / 256.0f) + 1e-6f);
            float y[16];
#pragma unroll
            for (int hh = 0; hh < 2; ++hh)
#pragma unroll
                for (int q = 0; q < 4; ++q) {
                    y[8 * hh + 2 * q] = o[8 * hh + 2 * q] * rstd * ngv[8 * hh + 2 * q] * bf2f((unsigned short)(rv[i][hh][q] & 0xffff));
                    y[8 * hh + 2 * q + 1] = o[8 * hh + 2 * q + 1] * rstd * ngv[8 * hh + 2 * q + 1] * bf2f((unsigned short)(rv[i][hh][q] >> 16)); }
            u32x4 w0, w1;
            w0.x = cvt_pk_bf16(y[0], y[1]); w0.y = cvt_pk_bf16(y[2], y[3]); w0.z = cvt_pk_bf16(y[4], y[5]); w0.w = cvt_pk_bf16(y[6], y[7]);
            w1.x = cvt_pk_bf16(y[8], y[9]); w1.y = cvt_pk_bf16(y[10], y[11]); w1.z = cvt_pk_bf16(y[12], y[13]); w1.w = cvt_pk_bf16(y[14], y[15]);
            const size_t off = (size_t)(t0 + i) * DM + 16 * lane;
            *(u32x4*)(G + off) = w0; *(u32x4*)(G + off + 8) = w1;
        }
    }
}

constexpr int SC_QD = 0, SC_KI = 18432, SC_KDT = 36864, SC_VT = 57344, SC_ST = 77824, SC_P = 114688, SC_TOT = 124928, SC_DEC = 124928, SC_LA = 125440;
constexpr int PQ = 144, PS = 80;
__device__ __forceinline__ void gla_scan_phase(LAS unsigned char* lds, const bf16_t* QDf, const bf16_t* KIf, const bf16_t* QDb, const bf16_t* KIb, const float* ET, const bf16_t* VT, bf16_t* Of, bf16_t* Ob) {
    const int tid = opaque_tid(), w = __builtin_amdgcn_readfirstlane(tid >> 6), lane = tid & 63, fr = lane & 15, fq = lane >> 4;
    LAS bf16_t* QD = (LAS bf16_t*)(lds + SC_QD); LAS bf16_t* KI = (LAS bf16_t*)(lds + SC_KI); LAS bf16_t* KDT = (LAS bf16_t*)(lds + SC_KDT);
    LAS bf16_t* VTs = (LAS bf16_t*)(lds + SC_VT); LAS bf16_t* ST = (LAS bf16_t*)(lds + SC_ST); LAS bf16_t* Pm = (LAS bf16_t*)(lds + SC_P);
    LAS float* TOT = (LAS float*)(lds + SC_TOT); LAS float* DEC = (LAS float*)(lds + SC_DEC);
    const int d = tid & 127, seg = tid >> 7;
    for (int item = blockIdx.x; item < 256; item += gridDim.x) {
        const int es = item & 1, dir = (item >> 1) & 1, h = (item >> 2) & 3, b = item >> 4;
        bf16_t* Od = dir ? Ob : Of;
        for (int i = tid; i < 128 * PQ / 2; i += 512) ((LAS unsigned*)ST)[i] = 0u;
        f32x4 S[8];
#pragma unroll
        for (int dt = 0; dt < 8; ++dt) S[dt] = (f32x4){0.f, 0.f, 0.f, 0.f};
        __syncthreads();
        const bf16_t* QDg = dir ? QDb : QDf; const bf16_t* KIg = dir ? KIb : KIf;
        u32x4 qv[2][2], kv[2][2], vtv[2][2]; f32x4 etv[2][2][2]; float decv[2] = {0.f, 0.f};
        const int krow = tid & 63, kc8 = (tid >> 6) * 8;
#define SCAN_TOK0(st) ((st) < 4 ? (TL + b * 256 + (dir ? 3 - (st) : (st)) * 64) : (b * 2048 + (dir ? 31 - ((st) - 4) : ((st) - 4)) * 64))
#define SCAN_LOAD(st, S) do { const int _t0 = SCAN_TOK0(st); const float* _et = ET + ((size_t)(_t0 >> 6) * 2 + dir) * 512 + h * 128; \
            _Pragma("unroll") for (int i = 0; i < 2; ++i) { const int piece = tid + 512 * i; const int row = piece >> 4, c8 = (piece & 15) * 8; \
                qv[S][i] = *(const u32x4*)(QDg + (size_t)(_t0 + row) * 512 + h * 128 + c8); \
                kv[S][i] = *(const u32x4*)(KIg + (size_t)(_t0 + krow) * 512 + h * 128 + kc8 + 64 * i); \
                etv[S][i][0] = *(const f32x4*)(_et + kc8 + 64 * i); etv[S][i][1] = *(const f32x4*)(_et + kc8 + 64 * i + 4); \
                const int er = piece >> 3, pc = piece & 7; vtv[S][i] = *(const u32x4*)(VT + (size_t)(h * 256 + es * 128 + er) * TT + _t0 + 8 * pc); } \
            if (tid < 128) decv[S] = _et[tid]; } while (0)
        SCAN_LOAD(0, 0); SCAN_LOAD(1, 1);
        for (int step2 = 0; step2 < 36; step2 += 2) {
#pragma unroll
          for (int ss = 0; ss < 2; ++ss) {
            const int step = step2 + ss;
            const int tok0 = SCAN_TOK0(step);
#pragma unroll
            for (int i = 0; i < 2; ++i) { const int piece = tid + 512 * i; const int row = piece >> 4, c8 = (piece & 15) * 8;
                *(LAS u32x4*)(QD + row * PQ + c8) = qv[ss][i];
                *(LAS u32x4*)(KI + krow * PQ + kc8 + 64 * i) = kv[ss][i];
                const f32x4 e0 = etv[ss][i][0], e1 = etv[ss][i][1];
#pragma unroll
                for (int q = 0; q < 4; ++q) { const float klo = bf2f((unsigned short)(kv[ss][i][q] & 0xffff)), khi = bf2f((unsigned short)(kv[ss][i][q] >> 16));
                    const float elo = (2 * q < 4) ? e0[(2 * q) & 3] : e1[(2 * q) & 3], ehi = (2 * q + 1 < 4) ? e0[(2 * q + 1) & 3] : e1[(2 * q + 1) & 3];
                    KDT[(kc8 + 64 * i + 2 * q) * PS + krow] = f2bf(klo * elo); KDT[(kc8 + 64 * i + 2 * q + 1) * PS + krow] = f2bf(khi * ehi); }
                const int er = piece >> 3, pc = piece & 7; *(LAS u32x4*)(VTs + er * PS + 8 * pc) = vtv[ss][i]; }
            if (tid < 128) DEC[tid] = decv[ss];
            __syncthreads();
            if (step + 2 < 36) SCAN_LOAD(step + 2, ss);
#define FRAG(base, row, pitch, ks) (*(const LAS bf16x8*)((base) + (row) * (pitch) + (ks) * 32 + fq * 8))
            {
                const int id0 = 2 * w, ct0 = id0 >> 2, st0 = id0 & 3, st1 = st0 + 1;
                bf16x8 qa[4], kb0[4], kb1[4];
#pragma unroll
                for (int ks = 0; ks < 4; ++ks) { qa[ks] = FRAG(QD, ct0 * 16 + fr, PQ, ks); kb0[ks] = FRAG(KI, st0 * 16 + fr, PQ, ks); kb1[ks] = FRAG(KI, st1 * 16 + fr, PQ, ks); }
                bf16x8 sa[4];
#pragma unroll
                for (int ks = 0; ks < 4; ++ks) sa[ks] = FRAG(ST, 16 * w + fr, PQ, ks);
#pragma unroll
                for (int dt = 0; dt < 8; ++dt) { const f32x4 dcv = *(const LAS f32x4*)(DEC + 16 * dt + 4 * fq); S[dt] = S[dt] * dcv; }
                __builtin_amdgcn_sched_barrier(0);
                f32x4 a0 = (f32x4){0.f, 0.f, 0.f, 0.f}, a1 = a0;
#pragma unroll
                for (int ks = 0; ks < 4; ++ks) { a0 = __builtin_amdgcn_mfma_f32_16x16x32_bf16(qa[ks], kb0[ks], a0, 0, 0, 0); a1 = __builtin_amdgcn_mfma_f32_16x16x32_bf16(qa[ks], kb1[ks], a1, 0, 0, 0); }
#pragma unroll
                for (int rg = 0; rg < 4; ++rg) { const int c_ = ct0 * 16 + 4 * fq + rg; const int s0_ = st0 * 16 + fr, s1_ = st1 * 16 + fr;
                    const bool k0_ = dir == 0 ? (s0_ <= c_) : (s0_ >= c_), k1_ = dir == 0 ? (s1_ <= c_) : (s1_ >= c_);
                    Pm[c_ * PS + s0_] = k0_ ? f2bf(a0[rg]) : (bf16_t)0; Pm[c_ * PS + s1_] = k1_ ? f2bf(a1[rg]) : (bf16_t)0; }
                f32x4 oacc[4];
#pragma unroll
                for (int ct = 0; ct < 4; ++ct) oacc[ct] = (f32x4){0.f, 0.f, 0.f, 0.f};
#pragma unroll
                for (int ct = 0; ct < 4; ++ct) {
                    bf16x8 qb[4];
#pragma unroll
                    for (int ks = 0; ks < 4; ++ks) qb[ks] = FRAG(QD, 16 * ct + fr, PQ, ks);
#pragma unroll
                    for (int ks = 0; ks < 4; ++ks) oacc[ct] = __builtin_amdgcn_mfma_f32_16x16x32_bf16(sa[ks], qb[ks], oacc[ct], 0, 0, 0);
                }
                __syncthreads();
                bf16x8 va[2], pb[4][2];
#pragma unroll
                for (int ks = 0; ks < 2; ++ks) { va[ks] = FRAG(VTs, 16 * w + fr, PS, ks);
#pragma unroll
                    for (int ct = 0; ct < 4; ++ct) pb[ct][ks] = FRAG(Pm, 16 * ct + fr, PS, ks); }
                __builtin_amdgcn_sched_barrier(0);
#pragma unroll
                for (int ks = 0; ks < 2; ++ks)
#pragma unroll
                    for (int ct = 0; ct < 4; ++ct) oacc[ct] = __builtin_amdgcn_mfma_f32_16x16x32_bf16(va[ks], pb[ct][ks], oacc[ct], 0, 0, 0);
#pragma unroll
                for (int ct = 0; ct < 4; ++ct) { u32x2 wv; wv.x = cvt_pk_bf16(oacc[ct][0], oacc[ct][1]); wv.y = cvt_pk_bf16(oacc[ct][2], oacc[ct][3]);
                    *(u32x2*)(Od + (size_t)(tok0 + 16 * ct + fr) * DM + h * 256 + es * 128 + 16 * w + 4 * fq) = wv; }
#pragma unroll
                for (int half = 0; half < 2; ++half) {
                    bf16x8 ka[4][2];
#pragma unroll
                    for (int dd = 0; dd < 4; ++dd)
#pragma unroll
                        for (int ks = 0; ks < 2; ++ks) ka[dd][ks] = FRAG(KDT, 16 * (4 * half + dd) + fr, PS, ks);
                    __builtin_amdgcn_sched_barrier(0);
#pragma unroll
                    for (int ks = 0; ks < 2; ++ks)
#pragma unroll
                        for (int dd = 0; dd < 4; ++dd) S[4 * half + dd] = __builtin_amdgcn_mfma_f32_16x16x32_bf16(ka[dd][ks], va[ks], S[4 * half + dd], 0, 0, 0);
                }
#pragma unroll
                for (int dt = 0; dt < 8; ++dt) { u32x2 wv; wv.x = cvt_pk_bf16(S[dt][0], S[dt][1]); wv.y = cvt_pk_bf16(S[dt][2], S[dt][3]); *(LAS u32x2*)(ST + (16 * w + fr) * PQ + 16 * dt + 4 * fq) = wv; }
            }
#undef FRAG
            __syncthreads();
          }
        }
    }
}

#undef SCAN_LOAD
#undef SCAN_TOK0
__global__ void __launch_bounds__(512, 2) fwd_megakernel(Params P) {
    extern __shared__ __attribute__((aligned(16))) unsigned char lds_raw[];
    LAS unsigned char* lds = (LAS unsigned char*)lds_raw;
    cg::grid_group grid = cg::this_grid();
#define GSYNC0() do { asm volatile("s_waitcnt vmcnt(0) lgkmcnt(0)" ::: "memory"); __syncthreads(); grid.sync(); asm volatile("s_waitcnt vmcnt(0) lgkmcnt(0)" ::: "memory"); __syncthreads(); } while (0)
    volatile LAS unsigned* xb_st = (volatile LAS unsigned*)(lds + LDS_BYTES - 16);
    if (threadIdx.x == 0) { xb_st[0] = 0u; xb_st[1] = 0u; }
    __syncthreads();
    const XcdBarrier xbar = xcd_barrier_post((unsigned*)(P.ws + WS_CTL), xb_st);
    grid.sync();
#define GSYNC() xcd_barrier(xbar)
    const int G = gridDim.x, bx = blockIdx.x;
    unsigned char* ws = P.ws;
    float* mod = (float*)(ws + WS_MOD);
    float* Xl = P.out; float* Xc = (float*)(ws + WS_XCTX);
    bf16_t* HZ = (bf16_t*)(ws + WS_HZ); bf16_t* BIG = (bf16_t*)(ws + WS_BIG);
    bf16_t* QDf = (bf16_t*)(ws + WS_BIG); bf16_t* KIf = (bf16_t*)(ws + WS_BIG + 36 * MiB); bf16_t* QDb = (bf16_t*)(ws + WS_BIG + 72 * MiB); bf16_t* KIb = (bf16_t*)(ws + WS_BIG + 108 * MiB); bf16_t* VTb = (bf16_t*)(ws + WS_BIG + BIG_VT);
    float* ETb = (float*)(ws + WS_ET);
    bf16_t* Rb = (bf16_t*)(ws + WS_R); bf16_t* Obb = (bf16_t*)(ws + WS_OB);
    bf16_t* Dpb = (bf16_t*)(ws + WS_OB);
    bf16_t* Db = (bf16_t*)(ws + WS_R);

#ifndef NO_ADA
    ada_phase(lds, P);
#endif
    GSYNC();
#pragma unroll 1
    for (int layer = 0; layer < 4; ++layer) {
        const int kind = layer & 1, j = layer >> 1; const bool last = layer == 3;
        const float* modl = mod + (size_t)layer * NCOND * NADA;
        const float* src_lat = layer == 0 ? P.in[I_X] : Xl; const float* src_ctx = layer == 0 ? P.in[I_CTX] : Xc;
        const int Mall = TT, Mres = last ? TL : TT;
        unsigned char* wb = ws + ((layer & 1) ? WS_W2 : 0);
        bf16_t* Win_t = (bf16_t*)(wb + WS_WIN); bf16_t* Wout_t = (bf16_t*)(wb + WS_WOUT); bf16_t* Wf1_t = (bf16_t*)(wb + WS_WF1); bf16_t* Wf2_t = (bf16_t*)(wb + WS_WF2);
#ifndef NO_PREP
        prep_layer(lds, P, layer, 0, G);
#endif
        norm_mod_phase(src_lat, src_ctx, layer == 0 ? (const bf16_t*)nullptr : Db, Dpb, layer == 0 ? (float*)nullptr : Xl, Xc, P.in[I_N1G] + layer * DM, modl, 0, 1024, HZ, Mall);
        GSYNC();
        if (kind == 1) {
            pg8::Gemm g{HZ, Win_t, Mall, 3072, 1024}; pg8::StaticOrder S; S.init(Mall, 3072, 1024, G, bx);
            EpiGla E{QDf, KIf, QDb, KIb, Rb, ETb, P.in[I_GBR] + j * 1024, P.in[I_GBA] + j * 1024};
#ifndef NO_GGLA
            pg8::gemm_phase<EpiGla>(lds, g, S, E);
#endif
        }
        if (kind == 0) {
            pg8::Gemm g{HZ, Win_t, Mall, 3072, 1024}; pg8::StaticOrder S; S.init(Mall, 3072, 1024, G, bx);
            EpiConvIn E{BIG};
#ifndef NO_GPLAIN
            pg8::gemm_phase<EpiConvIn>(lds, g, S, E);
#endif
        } else {
            pg8::Gemm g{Win_t + (size_t)3072 * 1024, HZ, 1024, Mall, 1024}; pg8::StaticOrder S; S.init(1024, Mall, 1024, G, (bx + 64) % G);
            EpiPlain E{VTb, (size_t)TT};
#ifndef NO_GPLAIN
            pg8::gemm_phase<EpiPlain>(lds, g, S, E);
#endif
        }
        GSYNC();
        const bf16_t* Aout;
        if (kind == 0) {
            conv_phase(BIG, P.in[I_CW] + j * 3 * 1024, HZ, Mres);
            Aout = HZ;
        } else {
#ifndef NO_SCAN
            gla_scan_phase(lds, QDf, KIf, QDb, KIb, ETb, VTb, HZ, Obb);
#endif
            GSYNC();
            gla_out_phase(HZ, Obb, Rb, P.in[I_GNG] + j * 256, BIG, Mres);
            Aout = BIG;
        }
        GSYNC();
        {
            pg8::Gemm g{Aout, Wout_t, Mres, 1024, 1024};
            EpiDelta E{Db, modl + 2048, Dpb, last ? 0 : 1};
#ifndef NO_GRES
            if (last) { pg8::StaticOrder S; S.init(Mres, 1024, 1024, G, bx); pg8::gemm_phase<EpiDelta>(lds, g, S, E); }
            else { pg8::TailOrder S; S.init(1024, 1024, G, bx); pg8::gemm_phase<EpiDelta, pg8::TailOrder>(lds, g, S, E); }
#endif
        }
        GSYNC();
        norm_mod_phase(src_lat, src_ctx, Db, last ? (const bf16_t*)nullptr : Dpb, Xl, Xc, P.in[I_N2G] + layer * DM, modl, 3072, 4096, HZ, Mres);
        GSYNC();
        {
            pg8::Gemm g{HZ, Wf1_t, Mres, 5632, 1024}; pg8::StaticOrder S; S.init(Mres, 5632, 1024, G, bx);
            EpiSwiglu E{BIG};
#ifndef NO_GSWI
            pg8::gemm_phase<EpiSwiglu>(lds, g, S, E);
#endif
        }
        GSYNC();
        {
            pg8::Gemm g{BIG, Wf2_t, Mres, 1024, 2816};
            EpiDelta E{Db, modl + 5120, Dpb, last ? 0 : 1};
#ifndef NO_GRES
            if (last) { pg8::StaticOrder S; S.init(Mres, 1024, 2816, G, bx); pg8::gemm_phase<EpiDelta>(lds, g, S, E); }
            else { pg8::TailOrder S; S.init(1024, 2816, G, bx); pg8::gemm_phase<EpiDelta, pg8::TailOrder>(lds, g, S, E); }
#endif
        }
        GSYNC();
    }
    final_norm_phase(Xl, Db, P.in[I_FG], P.out);
}

extern "C" void kernel_launch(void* const* d_in, const int* in_sizes, int n_in, void* d_out, int out_size, void* d_ws, size_t ws_size, hipStream_t stream) {
    static int grid_blocks = 0;
    if (grid_blocks == 0) {
        if (n_in != 21 || ws_size < WS_END) { fprintf(stderr, "kernel_launch: unexpected n_in %d / ws_size %zu (need %zu)\n", n_in, ws_size, (size_t)WS_END); grid_blocks = -1; return; }
        int dev = 0, cus = 0, per_cu = 0;
        hipGetDevice(&dev);
        hipDeviceGetAttribute(&cus, hipDeviceAttributeMultiprocessorCount, dev);
        if (hipFuncSetAttribute((const void*)fwd_megakernel, hipFuncAttributeMaxDynamicSharedMemorySize, LDS_BYTES) != hipSuccess) { fprintf(stderr, "kernel_launch: hipFuncSetAttribute failed\n"); grid_blocks = -1; return; }
        if (hipOccupancyMaxActiveBlocksPerMultiprocessor(&per_cu, (const void*)fwd_megakernel, 512, LDS_BYTES) != hipSuccess || per_cu < 1) { fprintf(stderr, "kernel_launch: occupancy query says %d\n", per_cu); per_cu = 1; }
        (void)hipGetLastError();
        grid_blocks = cus;
    }
    if (grid_blocks < 0) return;
    if (hipMemsetAsync((char*)d_ws + WS_CTL, 0, XCD_BAR_WORDS * 4, stream) != hipSuccess) { fprintf(stderr, "kernel_launch: memset of the barrier words failed\n"); return; }
    Params p{};
    for (int i = 0; i < 21; ++i) p.in[i] = (const float*)d_in[i];
    p.out = (float*)d_out; p.ws = (unsigned char*)d_ws;
    void* args[] = {&p};
    hipError_t e = hipLaunchCooperativeKernel((const void*)fwd_megakernel, dim3(grid_blocks), dim3(512), args, LDS_BYTES, stream);
    if (e != hipSuccess) fprintf(stderr, "cooperative launch failed: %s (grid %d)\n", hipGetErrorString(e), grid_blocks);
}
```

```cpp
#include <hip/hip_runtime.h>
#include <hip/hip_cooperative_groups.h>
#include <cstdio>
#include <cstdint>
namespace cg = cooperative_groups;

#define LAS __attribute__((address_space(3)))
typedef unsigned short bf16_t;
typedef short bf16x8 __attribute__((ext_vector_type(8)));
typedef float f32x4 __attribute__((ext_vector_type(4)));
typedef float f32x2 __attribute__((ext_vector_type(2)));
typedef unsigned u32x4 __attribute__((ext_vector_type(4)));
typedef unsigned u32x2 __attribute__((ext_vector_type(2)));

constexpr int DM = 1024, TL = 32768, TC = 4096, TT = TL + TC, DFF = 2816, NCOND = 17, NADA = 6144;
constexpr int LDS_BYTES = 147456;
constexpr size_t MiB = 1u << 20;
constexpr size_t WS_WIN = 0, WS_WOUT = 8 * MiB, WS_WF1 = 10 * MiB, WS_WF2 = 21 * MiB, WS_MOD = 27 * MiB, WS_XCTX = 29 * MiB,
                 WS_HZ = 45 * MiB, WS_BIG = 117 * MiB, WS_R = 333 * MiB, WS_OB = 405 * MiB, WS_W2 = 477 * MiB  , WS_CTL = 504 * MiB, WS_ET = 505 * MiB  , WS_END = 508 * MiB;
constexpr size_t BIG_Q = 0, BIG_K = 36 * MiB, BIG_LA = 72 * MiB, BIG_VT = 144 * MiB;

struct Params { const float* in[21]; float* out; unsigned char* ws; };
enum { I_X = 0, I_C, I_CTX, I_CCTX, I_ADAW, I_ADAB, I_N1G, I_N2G, I_CWIN, I_CW, I_CWOUT, I_GWIN, I_GBR, I_GA1, I_GA2, I_GBA, I_GNG, I_GWOUT, I_FWIN, I_FWOUT, I_FG };

typedef __bf16 bf16x2v __attribute__((ext_vector_type(2)));
__device__ __forceinline__ unsigned cvt_pk_bf16(float lo, float hi) { f32x2 v = {lo, hi}; bf16x2v b = __builtin_convertvector(v, bf16x2v); return __builtin_bit_cast(unsigned, b); }
__device__ __forceinline__ float bf2f(unsigned short b) { return __uint_as_float(((unsigned)b) << 16); }
__device__ __forceinline__ unsigned short f2bf(float f) { return (unsigned short)(cvt_pk_bf16(f, 0.f) & 0xffffu); }
__device__ __forceinline__ float silu_f(float v) { return v * __builtin_amdgcn_rcpf(1.0f + __expf(-v)); }
__device__ __forceinline__ float wave_sum(float v) {
#pragma unroll
    for (int o = 1; o < 64; o <<= 1) v += __shfl_xor(v, o);
    return v;
}
__device__ __forceinline__ int opaque_tid() { int t = threadIdx.x; asm volatile("" : "+v"(t)); return t; }

__device__ __forceinline__ void grid_bar(unsigned* ctr, unsigned target) {
    asm volatile("s_waitcnt vmcnt(0) lgkmcnt(0)" ::: "memory");
    __syncthreads();
    if (threadIdx.x == 0) {
        __builtin_amdgcn_fence(__ATOMIC_RELEASE, "agent");
        asm volatile("s_waitcnt vmcnt(0)" ::: "memory");
        __hip_atomic_fetch_add(ctr, 1u, __ATOMIC_RELAXED, __HIP_MEMORY_SCOPE_AGENT);
        __builtin_amdgcn_fence(__ATOMIC_ACQUIRE, "agent");
        unsigned polls = 0; const unsigned long long t0 = __builtin_amdgcn_s_memrealtime();
        while ((int)(__hip_atomic_load(ctr, __ATOMIC_RELAXED, __HIP_MEMORY_SCOPE_AGENT) - target) < 0) {
            __builtin_amdgcn_s_sleep(1);
            if ((++polls & 255u) == 0u && __builtin_amdgcn_s_memrealtime() - t0 > 200000000ull) break;
        }
        asm volatile("s_waitcnt vmcnt(0)" ::: "memory");
    }
    __syncthreads();
}

#define XB_TMO      128
#define XB_XCNT(j)  (256  + 64 * (j))
#define XB_XSUB(j)  (1280 + 64 * (j))
#define XB_XGEN(j)  (2304 + 64 * (j))
#define XB_TOP      3328
#define XB_TOPGEN   3392
#define XCD_BAR_WORDS 3456
#define XB_SPIN_CAP (1u << 18)
__device__ __forceinline__ unsigned xb_ld(unsigned* p)              { return __hip_atomic_load(p, __ATOMIC_RELAXED, __HIP_MEMORY_SCOPE_AGENT); }
__device__ __forceinline__ unsigned xb_add(unsigned* p, unsigned v) { return __hip_atomic_fetch_add(p, v, __ATOMIC_RELAXED, __HIP_MEMORY_SCOPE_AGENT); }
__device__ __forceinline__ unsigned xb_xcc_id() { return (unsigned)__builtin_amdgcn_s_getreg((3 << 11) | 20) & 0xFu; }
#define XB_SPIN(cond, bar) do { unsigned _sp = 0; while (cond) { __builtin_amdgcn_s_sleep(1); \
    if ((++_sp & 255u) == 0u) { if (xb_ld(&(bar)[XB_TMO])) break; if (_sp > XB_SPIN_CAP) { atomicAdd(&(bar)[XB_TMO], 1u); break; } } } } while (0)
struct XcdBarrier { unsigned* bar; unsigned x; volatile LAS unsigned* st; };
__device__ __forceinline__ XcdBarrier xcd_barrier_post(unsigned* bar, volatile LAS unsigned* st) {
    XcdBarrier b; b.bar = bar; b.x = xb_xcc_id(); b.st = st;
    if (threadIdx.x == 0) (void)xb_add(&bar[XB_XCNT(b.x)], 1u);
    return b;
}
__device__ __forceinline__ void xcd_barrier_complete(unsigned* bar, unsigned x, unsigned& nloc, unsigned& nx) {
    const unsigned G = gridDim.x * gridDim.y * gridDim.z;
    unsigned sum, cnt, mine, sp = 0u;
    for (;;) {
        sum = 0u; cnt = 0u; mine = 0u;
#pragma unroll
        for (unsigned j = 0; j < 16; ++j) { const unsigned c = xb_ld(&bar[XB_XCNT(j)]); sum += c; cnt += (c > 0u) ? 1u : 0u; mine = (j == x) ? c : mine; }
        if (sum == G) break;
        __builtin_amdgcn_s_sleep(1);
        if ((++sp & 255u) == 0u) { if (xb_ld(&bar[XB_TMO])) break; if (sp > XB_SPIN_CAP) { atomicAdd(&bar[XB_TMO], 1u); break; } }
    }
    nloc = mine > 0u ? mine : 1u; nx = cnt > 0u ? cnt : 1u;
}
__device__ __forceinline__ void xcd_barrier(const XcdBarrier& b) {
    asm volatile("s_waitcnt vmcnt(0) lgkmcnt(0)" ::: "memory");
    __syncthreads();
    if (threadIdx.x == 0) {
        unsigned* bar = b.bar;
        __builtin_amdgcn_s_waitcnt(0);
        unsigned nloc = b.st[0], nx = b.st[1];
        if (nloc == 0u) { xcd_barrier_complete(bar, b.x, nloc, nx); b.st[0] = nloc; b.st[1] = nx; }
        const unsigned old = xb_add(&bar[XB_XSUB(b.x)], 1u);
        const unsigned gen = old / nloc;
        if (old + 1u == (gen + 1u) * nloc) {
            __builtin_amdgcn_fence(__ATOMIC_RELEASE, "agent");
            asm volatile("s_waitcnt vmcnt(0)" ::: "memory");
            const unsigned og = xb_add(&bar[XB_TOP], 1u);
            const unsigned tg = og / nx;
            __builtin_amdgcn_fence(__ATOMIC_ACQUIRE, "agent");
            if (og + 1u == (tg + 1u) * nx) xb_add(&bar[XB_TOPGEN], 1u);
            else XB_SPIN(xb_ld(&bar[XB_TOPGEN]) == tg, bar);
            xb_add(&bar[XB_XGEN(b.x)], 1u);
            asm volatile("s_waitcnt vmcnt(0)" ::: "memory");
        } else {
            __builtin_amdgcn_fence(__ATOMIC_ACQUIRE, "agent");
            XB_SPIN(xb_ld(&bar[XB_XGEN(b.x)]) == gen, bar);
            asm volatile("s_waitcnt vmcnt(0)" ::: "memory");
        }
    }
    __syncthreads();
}
#define LDS_WAIT() asm volatile("s_waitcnt lgkmcnt(0)" ::: "memory")

namespace pg8 {
constexpr int BM = 256, BK = 64, HALF = 128, HTB = HALF * BK * 2, STAGE_BYTES = 8 * HTB, NXCD = 8, WGM = 8;
__host__ __device__ __forceinline__ int lds_byte(int r, int c) { const int st = (r >> 4) * 2 + (c >> 5), rr = r & 15, cc = c & 31, ob = rr * 64 + cc * 2; return st * 1024 + (ob ^ (((ob >> 9) & 1) << 5)); }
__host__ __device__ __forceinline__ void stage_rc(int b, int& R, int& C) { const int st = b / 1024, sb = b % 1024, swz = sb ^ (((sb >> 9) & 1) << 5); R = (st >> 1) * 16 + swz / 64; C = (st & 1) * 32 + (swz % 64) / 2; }

__host__ __device__ __forceinline__ int perm32(int rho) { const int n = rho >> 4, i = rho & 15; return 8 * (i >> 2) + 4 * n + (i & 3); }
struct Unit { int pm, pn, k0, nt, part; };
struct Gemm { const bf16_t* A; const bf16_t* Bt; int M, N, K; };

struct StaticOrder {
    int nM, nN, nwg, G, c, ktiles;
    __host__ __device__ void init(int M, int N, int K, int G_, int c_) { nM = M / BM; nN = N / BM; nwg = nM * nN; G = G_; c = c_; ktiles = K / BK; }
    __host__ __device__ __forceinline__ int map(int L) const {
        int wgid = L; { const int q = nwg / NXCD, r = nwg % NXCD, xcd = wgid % NXCD, off = wgid / NXCD; wgid = (xcd < r ? xcd * (q + 1) : r * (q + 1) + (xcd - r) * q) + off; }
        const int nig = WGM * nN, gid = wgid / nig, fm = gid * WGM, gsz = (nM - fm) < WGM ? (nM - fm) : WGM;
        return ((fm + ((wgid % nig) % gsz)) << 16) | ((wgid % nig) / gsz);
    }
    __host__ __device__ __forceinline__ bool next(int i, Unit& u) const {
        const long L = (long)i * G + c; if (L >= nwg) return false;
        const int pp = map((int)L); Unit t; t.pm = pp >> 16; t.pn = pp & 0xffff; t.k0 = 0; t.nt = ktiles; t.part = 0; u = t; return true;
    }
};
struct TailOrder {
    StaticOrder lat; int q, r;
    __host__ __device__ void init(int N, int K, int G_, int c_) { lat.init(TL, N, K, G_, c_); const int kt = K / BK; q = (kt / 4) & ~1; r = kt - 4 * q; }
    __host__ __device__ __forceinline__ bool next(int i, Unit& u) const {
        const long L = (long)i * lat.G + lat.c;
        const int s = (int)(L - lat.nwg); if (s >= 64 * 4) return false;
        const bool whole = L < lat.nwg;
        const int pp = lat.map(whole ? (int)L : 0);
        const int part = s & 3, h2 = r >> 1;
        Unit t;
        t.pm = whole ? (pp >> 16) : TL / BM + (s >> 4); t.pn = whole ? (pp & 0xffff) : ((s >> 2) & 3);
        t.k0 = whole ? 0 : part * q + 2 * (part < h2 ? part : h2); t.nt = whole ? lat.ktiles : q + (part < h2 ? 2 : 0); t.part = whole ? 0 : part;
        u = t; return true;
    }
};

template <class Epi, class Sched = StaticOrder, bool ALIGN_EPI = true>
__device__ __forceinline__ void gemm_phase(LAS unsigned char* lds, const Gemm g, const Sched& S, const Epi& E) {
    const int tid = opaque_tid(), wid = __builtin_amdgcn_readfirstlane(tid >> 6), lane = tid & 63, wr = wid >> 2, wc = wid & 3, fr = lane & 15, fq = lane >> 4;
    const int K = g.K;
    unsigned voffA[2], voffB[2];
#pragma unroll
    for (int i = 0; i < 2; ++i) { int R, C; stage_rc(tid * 16 + i * 8192, R, C); const int Rb = (R & ~31) + perm32(R & 31); voffA[i] = (unsigned)(R * K + C) * 2u; voffB[i] = (unsigned)(Rb * K + C) * 2u; }
    const size_t kstep = (size_t)(BK * 2);
    const size_t hstep = (size_t)HALF * K * 2;
    const size_t tstep = 2 * hstep;
    const unsigned ldsw = (unsigned)wid * 1024u;
    const int aoff = lds_byte(wr * 64 + fr, fq * 8), boff = lds_byte(wc * 32 + fr, fq * 8);
#define PG8_SA(b, h) (((b) * 2 + (h)) * HTB)
#define PG8_SB(b, h) ((4 + (b) * 2 + (h)) * HTB)
#define PG8_STAGE(bufoff, gbase, voff) do { _Pragma("unroll") for (int _i = 0; _i < 2; ++_i) \
        __builtin_amdgcn_global_load_lds((const unsigned*)((const char*)(gbase) + (voff)[_i]), (LAS unsigned*)(lds + (bufoff) + ldsw + _i * 8192), 16, 0, 0); } while (0)
#define PG8_LDA(dst, b, h) do { _Pragma("unroll") for (int m = 0; m < 4; ++m) _Pragma("unroll") for (int k = 0; k < 2; ++k) dst[m][k] = *(const LAS bf16x8*)(lds + PG8_SA(b, h) + aoff + m * 2048 + k * 1024); } while (0)
#define PG8_LDB(dst, b, h) do { _Pragma("unroll") for (int n = 0; n < 2; ++n) _Pragma("unroll") for (int k = 0; k < 2; ++k) dst[n][k] = *(const LAS bf16x8*)(lds + PG8_SB(b, h) + boff + n * 2048 + k * 1024); } while (0)
#define PG8_MMA(ai, bj, At, Bt) do { __builtin_amdgcn_s_setprio(1); _Pragma("unroll") for (int m = 0; m < 4; ++m) _Pragma("unroll") for (int n = 0; n < 2; ++n) _Pragma("unroll") for (int k = 0; k < 2; ++k) \
        acc[ai][bj][m][n] = __builtin_amdgcn_mfma_f32_16x16x32_bf16(Bt[n][k], At[m][k], acc[ai][bj][m][n], 0, 0, 0); __builtin_amdgcn_s_setprio(0); } while (0)
#define PG8_WAIT_V(n) asm volatile("s_waitcnt vmcnt(" #n ")" ::: "memory")
#define PG8_WAIT_L(n) asm volatile("s_waitcnt lgkmcnt(" #n ")" ::: "memory")
#define PG8_BAR __builtin_amdgcn_s_barrier()
#define PG8_SCHED __builtin_amdgcn_sched_barrier(0)
    Unit cur, nxt; int ui = 0;
    if (!S.next(0, cur)) return;
    f32x4 acc[2][2][4][2];
#pragma unroll
    for (int a = 0; a < 2; ++a)
#pragma unroll
        for (int b = 0; b < 2; ++b)
#pragma unroll
            for (int m = 0; m < 4; ++m)
#pragma unroll
                for (int n = 0; n < 2; ++n) acc[a][b][m][n] = (f32x4){0.f, 0.f, 0.f, 0.f};
    bf16x8 At[4][2], B0[2][2], B1[2][2];
    const char* cA = (const char*)g.A + (size_t)cur.pm * tstep + (size_t)cur.k0 * kstep; const char* cB = (const char*)g.Bt + (size_t)cur.pn * tstep + (size_t)cur.k0 * kstep;
    PG8_STAGE(PG8_SB(0, 0), cB, voffB); PG8_STAGE(PG8_SB(0, 1), cB + hstep, voffB); PG8_STAGE(PG8_SA(0, 0), cA, voffA); PG8_STAGE(PG8_SA(0, 1), cA + hstep, voffA);
    if (wr == 1) PG8_BAR;
    PG8_WAIT_V(2); PG8_BAR;
    PG8_STAGE(PG8_SB(1, 0), cB + kstep, voffB); PG8_STAGE(PG8_SA(1, 0), cA + kstep, voffA); PG8_STAGE(PG8_SB(1, 1), cB + hstep + kstep, voffB);
    PG8_WAIT_V(6); PG8_BAR;
    for (;;) {
        const bool has_next = S.next(ui + 1, nxt);
        const char* nA = has_next ? (const char*)g.A + (size_t)nxt.pm * tstep + (size_t)nxt.k0 * kstep : cA; const char* nB = has_next ? (const char*)g.Bt + (size_t)nxt.pn * tstep + (size_t)nxt.k0 * kstep : cB;
        const int nt = cur.nt;
        for (int t = 0; t < nt; t += 2) {
            const bool last = (t == nt - 2);
            const char* a1 = cA + (size_t)(t + 1) * kstep;
            const char* a2 = last ? nA : cA + (size_t)(t + 2) * kstep; const char* b2 = last ? nB : cB + (size_t)(t + 2) * kstep;
            const char* a3 = a2 + kstep; const char* b3 = b2 + kstep;
            PG8_LDB(B0, 0, 0); PG8_LDB(B1, 0, 1); PG8_SCHED; PG8_LDA(At, 0, 0); PG8_STAGE(PG8_SA(1, 1), a1 + hstep, voffA);
            PG8_WAIT_V(8); PG8_WAIT_L(0); PG8_BAR; PG8_MMA(0, 0, At, B0); PG8_MMA(0, 1, At, B1); PG8_BAR; PG8_SCHED;
            PG8_LDA(At, 0, 1); PG8_STAGE(PG8_SB(0, 0), b2, voffB); PG8_STAGE(PG8_SB(0, 1), b2 + hstep, voffB); PG8_STAGE(PG8_SA(0, 0), a2, voffA);
            PG8_WAIT_V(8); PG8_WAIT_L(0); PG8_BAR; PG8_MMA(1, 0, At, B0); PG8_MMA(1, 1, At, B1); PG8_BAR; PG8_SCHED;
            PG8_LDB(B0, 1, 0); PG8_LDB(B1, 1, 1); PG8_SCHED; PG8_LDA(At, 1, 0); PG8_STAGE(PG8_SA(0, 1), a2 + hstep, voffA);
            PG8_WAIT_V(8); PG8_WAIT_L(0); PG8_BAR; PG8_MMA(0, 0, At, B0); PG8_MMA(0, 1, At, B1); PG8_BAR; PG8_SCHED;
            PG8_LDA(At, 1, 1); PG8_STAGE(PG8_SB(1, 0), b3, voffB); PG8_STAGE(PG8_SB(1, 1), b3 + hstep, voffB); PG8_STAGE(PG8_SA(1, 0), a3, voffA);
            PG8_WAIT_V(8); PG8_WAIT_L(0); PG8_BAR; PG8_MMA(1, 0, At, B0); PG8_MMA(1, 1, At, B1); PG8_BAR; PG8_SCHED;
        }
        if constexpr (ALIGN_EPI) { if (wr == 0) PG8_BAR; }
        E(acc, cur, wr, wc, fr, fq);
        if (!has_next) break;
#pragma unroll
        for (int a = 0; a < 2; ++a)
#pragma unroll
            for (int b = 0; b < 2; ++b)
#pragma unroll
                for (int m = 0; m < 4; ++m)
#pragma unroll
                    for (int n = 0; n < 2; ++n) acc[a][b][m][n] = (f32x4){0.f, 0.f, 0.f, 0.f};
        cur = nxt; cA = nA; cB = nB; ++ui;
        if constexpr (ALIGN_EPI) { if (wr == 1) PG8_BAR; }
    }
    PG8_WAIT_V(0);
    if constexpr (!ALIGN_EPI) { if (wr == 0) PG8_BAR; }
    PG8_BAR;
#undef PG8_SA
#undef PG8_SB
#undef PG8_STAGE
#undef PG8_LDA
#undef PG8_LDB
#undef PG8_MMA
#undef PG8_WAIT_V
#undef PG8_WAIT_L
#undef PG8_BAR
#undef PG8_SCHED
}
}
using pg8::Unit;
typedef f32x4 AccT[2][2][4][2];

#define PACK8(v0, v1) (u32x4){cvt_pk_bf16((v0)[0], (v0)[1]), cvt_pk_bf16((v0)[2], (v0)[3]), cvt_pk_bf16((v1)[0], (v1)[1]), cvt_pk_bf16((v1)[2], (v1)[3])}
struct EpiPlain {
    bf16_t* O; size_t ldc;
    __device__ __forceinline__ void operator()(const AccT& acc, const Unit& u, int wr, int wc, int fr, int fq) const {
        const int row0 = u.pm * 256 + wr * 64 + fr, col0 = u.pn * 256 + wc * 32 + 8 * fq;
#pragma unroll
        for (int ai = 0; ai < 2; ++ai)
#pragma unroll
            for (int m = 0; m < 4; ++m) { bf16_t* rowp = O + (size_t)(row0 + ai * 128 + m * 16) * ldc + col0;
#pragma unroll
                for (int bj = 0; bj < 2; ++bj) *(u32x4*)(rowp + bj * 128) = PACK8(acc[ai][bj][m][0], acc[ai][bj][m][1]); }
    }
};
struct EpiGla {
    bf16_t *QDf, *KIf, *QDb, *KIb, *R; float* ET; const float *b_r, *b_a;
    __device__ __forceinline__ void operator()(const AccT& acc, const Unit& u, int wr, int wc, int fr, int fq) const {
        const int row0 = u.pm * 256 + wr * 64 + fr;
        const int pn = u.pn;
        if (pn < 8) {
            const int d0 = 64 * pn + 16 * wc + 4 * fq;
            const f32x4 baf = *(const f32x4*)(b_a + d0), bab = *(const f32x4*)(b_a + 512 + d0);
#pragma unroll
            for (int ai = 0; ai < 2; ++ai) {
                f32x4 pf[4], pb[4];
#pragma unroll
                for (int m = 0; m < 4; ++m) {
                    const f32x4 xf = acc[ai][1][m][0] + baf, xb = acc[ai][1][m][1] + bab;
#pragma unroll
                    for (int j = 0; j < 4; ++j) { pf[m][j] = (fminf(xf[j], 0.f) - __logf(1.0f + __expf(-fabsf(xf[j])))) * 0.0625f; pb[m][j] = (fminf(xb[j], 0.f) - __logf(1.0f + __expf(-fabsf(xb[j])))) * 0.0625f; }
                }
                f32x4 lb[4];
#pragma unroll
                for (int m = 0; m < 4; ++m) lb[m] = pb[m];
#pragma unroll
                for (int dl = 1; dl < 16; dl <<= 1) {
#pragma unroll
                    for (int m = 0; m < 4; ++m)
#pragma unroll
                        for (int j = 0; j < 4; ++j) { const float tf = __shfl_up(pf[m][j], dl, 16), tb = __shfl_up(pb[m][j], dl, 16); if (fr >= dl) { pf[m][j] += tf; pb[m][j] += tb; } }
                }
                f32x4 of = (f32x4){0.f, 0.f, 0.f, 0.f}, ob = of;
#pragma unroll
                for (int m = 0; m < 4; ++m)
#pragma unroll
                    for (int j = 0; j < 4; ++j) { const float tf = __shfl(pf[m][j], 15, 16), tb = __shfl(pb[m][j], 15, 16); pf[m][j] += of[j]; pb[m][j] += ob[j]; of[j] += tf; ob[j] += tb; }
                const int rbase = row0 + ai * 128;
                if (fr == 0) { const int chunk = (u.pm * 256 + ai * 128 + wr * 64) >> 6; f32x4 e0, e1;
#pragma unroll
                    for (int j = 0; j < 4; ++j) { e0[j] = __expf(of[j]); e1[j] = __expf(ob[j]); }
                    *(f32x4*)(ET + ((size_t)chunk * 2 + 0) * 512 + d0) = e0; *(f32x4*)(ET + ((size_t)chunk * 2 + 1) * 512 + d0) = e1; }
#pragma unroll
                for (int m = 0; m < 4; ++m) {
                    const f32x4 q = acc[ai][0][m][0] * 0.08838834764831845f, k = acc[ai][0][m][1];
                    f32x4 qf, kf, qb, kb;
#pragma unroll
                    for (int j = 0; j < 4; ++j) { const float bfw = pf[m][j], bbw = ob[j] - pb[m][j] + lb[m][j];
                        const float ef = __expf(bfw), eb = __expf(bbw);
                        qf[j] = q[j] * ef; kf[j] = k[j] * __builtin_amdgcn_rcpf(ef); qb[j] = q[j] * eb; kb[j] = k[j] * __builtin_amdgcn_rcpf(eb); }
                    const size_t off = (size_t)(rbase + m * 16) * 512 + d0;
                    u32x2 w;
                    w.x = cvt_pk_bf16(qf[0], qf[1]); w.y = cvt_pk_bf16(qf[2], qf[3]); *(u32x2*)(QDf + off) = w;
                    w.x = cvt_pk_bf16(kf[0], kf[1]); w.y = cvt_pk_bf16(kf[2], kf[3]); *(u32x2*)(KIf + off) = w;
                    w.x = cvt_pk_bf16(qb[0], qb[1]); w.y = cvt_pk_bf16(qb[2], qb[3]); *(u32x2*)(QDb + off) = w;
                    w.x = cvt_pk_bf16(kb[0], kb[1]); w.y = cvt_pk_bf16(kb[2], kb[3]); *(u32x2*)(KIb + off) = w;
                }
            }
        } else {
            const int col0 = (pn - 8) * 256 + wc * 32 + 8 * fq;
            f32x4 bv[2][2];
#pragma unroll
            for (int bj = 0; bj < 2; ++bj)
#pragma unroll
                for (int n = 0; n < 2; ++n) bv[bj][n] = *(const f32x4*)(b_r + col0 + bj * 128 + n * 4);
#pragma unroll
            for (int ai = 0; ai < 2; ++ai)
#pragma unroll
                for (int m = 0; m < 4; ++m) { bf16_t* rowp = R + (size_t)(row0 + ai * 128 + m * 16) * 1024 + col0;
#pragma unroll
                    for (int bj = 0; bj < 2; ++bj) { f32x4 v0 = acc[ai][bj][m][0] + bv[bj][0], v1 = acc[ai][bj][m][1] + bv[bj][1];
#pragma unroll
                        for (int j = 0; j < 4; ++j) { v0[j] = silu_f(v0[j]); v1[j] = silu_f(v1[j]); }
                        *(u32x4*)(rowp + bj * 128) = PACK8(v0, v1); } }
        }
    }
};
struct EpiDelta {
    bf16_t* D; const float* gate; bf16_t* Dp; int split;
    __device__ __forceinline__ void operator()(const AccT& acc, const Unit& u, int wr, int wc, int fr, int fq) const {
        const int rt = u.pm * 256; const int b = rt >= TL ? 16 : (rt >> 11);
        const int colt = u.pn * 256 + wc * 32 + 8 * fq;
        const float* gp = gate + (size_t)b * NADA + colt;
        f32x4 gv[2][2];
#pragma unroll
        for (int bj = 0; bj < 2; ++bj)
#pragma unroll
            for (int n = 0; n < 2; ++n) gv[bj][n] = *(const f32x4*)(gp + bj * 128 + n * 4);
#pragma unroll
        for (int ai = 0; ai < 2; ++ai)
#pragma unroll
            for (int m = 0; m < 4; ++m) { bf16_t* rowp = (split && rt >= TL ? Dp + (size_t)u.part * TC * DM + (size_t)(rt - TL + wr * 64 + fr + ai * 128 + m * 16) * DM : D + (size_t)(rt + wr * 64 + fr + ai * 128 + m * 16) * DM) + colt;
#pragma unroll
                for (int bj = 0; bj < 2; ++bj) { const f32x4 v0 = gv[bj][0] * acc[ai][bj][m][0], v1 = gv[bj][1] * acc[ai][bj][m][1]; *(u32x4*)(rowp + bj * 128) = PACK8(v0, v1); } }
    }
};
struct EpiConvIn {
    bf16_t* PU;
    __device__ __forceinline__ void operator()(const AccT& acc, const Unit& u, int wr, int wc, int fr, int fq) const {
        const int row0 = u.pm * 256 + wr * 64 + fr;
        if (u.pn < 4) {
            const int col0 = u.pn * 256 + wc * 32 + 8 * fq;
#pragma unroll
            for (int ai = 0; ai < 2; ++ai)
#pragma unroll
                for (int m = 0; m < 4; ++m) { bf16_t* rowp = PU + (size_t)(row0 + ai * 128 + m * 16) * 2048 + col0;
#pragma unroll
                    for (int bj = 0; bj < 2; ++bj) *(u32x4*)(rowp + bj * 128) = PACK8(acc[ai][bj][m][0], acc[ai][bj][m][1]); }
        } else {
            const int col0 = 1024 + (u.pn - 4) * 128 + wc * 32 + 8 * fq;
#pragma unroll
            for (int ai = 0; ai < 2; ++ai)
#pragma unroll
                for (int m = 0; m < 4; ++m) { bf16_t* rowp = PU + (size_t)(row0 + ai * 128 + m * 16) * 2048 + col0;
                    const f32x4 v0 = acc[ai][0][m][0] * acc[ai][1][m][0], v1 = acc[ai][0][m][1] * acc[ai][1][m][1];
                    *(u32x4*)(rowp) = PACK8(v0, v1); }
        }
    }
};
struct EpiSwiglu {
    bf16_t* F;
    __device__ __forceinline__ void operator()(const AccT& acc, const Unit& u, int wr, int wc, int fr, int fq) const {
        const int row0 = u.pm * 256 + wr * 64 + fr, col0 = u.pn * 128 + wc * 32 + 8 * fq;
#pragma unroll
        for (int ai = 0; ai < 2; ++ai)
#pragma unroll
            for (int m = 0; m < 4; ++m) { bf16_t* rowp = F + (size_t)(row0 + ai * 128 + m * 16) * DFF + col0;
                f32x4 v0, v1;
#pragma unroll
                for (int j = 0; j < 4; ++j) { v0[j] = silu_f(acc[ai][0][m][0][j]) * acc[ai][1][m][0][j]; v1[j] = silu_f(acc[ai][0][m][1][j]) * acc[ai][1][m][1][j]; }
                *(u32x4*)(rowp) = PACK8(v0, v1); }
    }
};

__device__ __forceinline__ void ada_phase(LAS unsigned char* lds, const Params& P) {
    LAS float* sc = (LAS float*)lds;
    LAS float* red = sc + NCOND * 1024;
    const int tid = opaque_tid(), wave = tid >> 6, lane = tid & 63;
    const float* c = P.in[I_C]; const float* cctx = P.in[I_CCTX]; const float* adaw = P.in[I_ADAW]; const float* adab = P.in[I_ADAB];
    float* mod = (float*)(P.ws + WS_MOD);
    if ((int)blockIdx.x >= 192) return;
    for (int idx = tid; idx < NCOND * 1024; idx += 512) { const int b = idx >> 10, k = idx & 1023; const float v = b < 16 ? c[b * 1024 + k] : cctx[k]; sc[idx] = silu_f(v); }
    __syncthreads();
    for (int item = blockIdx.x; item < 192; item += gridDim.x) {
        const int l = item / 48, n0 = (item % 48) * 128;
        float acc[NCOND][2];
#pragma unroll
        for (int b = 0; b < NCOND; ++b) { acc[b][0] = 0.f; acc[b][1] = 0.f; }
        const float* wbase = adaw + ((size_t)l * 1024) * NADA + n0 + 2 * lane;
        for (int k = 128 * wave; k < 128 * wave + 128; k += 16) {
            f32x2 wv[16];
#pragma unroll
            for (int i = 0; i < 16; ++i) wv[i] = __builtin_nontemporal_load((const f32x2*)(wbase + (size_t)(k + i) * NADA));
#pragma unroll
            for (int b = 0; b < NCOND; ++b) {
#pragma unroll
                for (int kk = 0; kk < 16; kk += 4) { const f32x4 s4 = *(const LAS f32x4*)(sc + b * 1024 + k + kk);
                    acc[b][0] += s4[0] * wv[kk][0] + s4[1] * wv[kk + 1][0] + s4[2] * wv[kk + 2][0] + s4[3] * wv[kk + 3][0];
                    acc[b][1] += s4[0] * wv[kk][1] + s4[1] * wv[kk + 1][1] + s4[2] * wv[kk + 2][1] + s4[3] * wv[kk + 3][1]; } }
        }
#pragma unroll
        for (int b = 0; b < NCOND; ++b) { red[(wave * NCOND + b) * 128 + 2 * lane] = acc[b][0]; red[(wave * NCOND + b) * 128 + 2 * lane + 1] = acc[b][1]; }
        __syncthreads();
        for (int idx = tid; idx < NCOND * 128; idx += 512) { const int b = idx >> 7, cc = idx & 127; float s = 0.f;
#pragma unroll
            for (int w = 0; w < 8; ++w) s += red[(w * NCOND + b) * 128 + cc];
            mod[((size_t)l * NCOND + b) * NADA + n0 + cc] = s + adab[l * NADA + n0 + cc]; }
        __syncthreads();
    }
}

__host__ __device__ __forceinline__ int qkl_row(int type, int d) { return 256 * (d >> 6) + 128 * (type >> 1) + 32 * ((d >> 4) & 3) + 8 * ((d >> 2) & 3) + 4 * (type & 1) + (d & 3); }
__device__ __forceinline__ void transpose_item(const float* W, int K, int N, bf16_t* WT, int wt_row0, int k0, int n0, LAS float* scr, int lane, int qkl_type = -1) {
#pragma unroll 8
    for (int i = 0; i < 32; ++i) { const int kk = 2 * i + (lane >> 5); scr[kk * 33 + (lane & 31)] = __builtin_nontemporal_load(W + (size_t)(k0 + kk) * N + n0 + (lane & 31)); }
    LDS_WAIT(); asm volatile("" ::: "memory");
    const int c = lane & 7;
#pragma unroll
    for (int j = 0; j < 4; ++j) { const int n = (lane >> 3) + 8 * j; const LAS float* s = scr + (8 * c) * 33 + n;
        u32x4 o; o.x = cvt_pk_bf16(s[0 * 33], s[1 * 33]); o.y = cvt_pk_bf16(s[2 * 33], s[3 * 33]); o.z = cvt_pk_bf16(s[4 * 33], s[5 * 33]); o.w = cvt_pk_bf16(s[6 * 33], s[7 * 33]);
        const int drow = qkl_type >= 0 ? qkl_row(qkl_type, wt_row0 + n) : wt_row0 + n;
        *(u32x4*)(WT + (size_t)drow * K + k0 + 8 * c) = o; }
    LDS_WAIT(); asm volatile("" ::: "memory");
}
__device__ __forceinline__ void prep_layer(LAS unsigned char* lds, const Params& P, int layer, int c0, int nblk) {
    const int tid = opaque_tid(), wave = tid >> 6, lane = tid & 63;
    const int kind = layer & 1, j = layer >> 1;
    LAS float* scr = (LAS float*)(lds + wave * 8704);
    unsigned char* wb = P.ws + ((layer & 1) ? WS_W2 : 0);
    bf16_t* Win_t = (bf16_t*)(wb + WS_WIN); bf16_t* Wout_t = (bf16_t*)(wb + WS_WOUT); bf16_t* Wf1_t = (bf16_t*)(wb + WS_WF1); bf16_t* Wf2_t = (bf16_t*)(wb + WS_WF2);
    const float* Win = (kind == 0 ? P.in[I_CWIN] : P.in[I_GWIN]) + (size_t)j * 1024 * 3072;
    const float* Wout = (kind == 0 ? P.in[I_CWOUT] : P.in[I_GWOUT]) + (size_t)j * 1024 * 1024;
    const float* Wf1 = P.in[I_FWIN] + (size_t)layer * 1024 * 5632;
    const float* Wf2 = P.in[I_FWOUT] + (size_t)layer * 2816 * 1024;
    const int gw = ((int)blockIdx.x - c0) * 8 + wave, NGW = nblk * 8;
    for (int it = gw; it < 6272; it += NGW) {
        if (it < 1536) { const int kb = it / 96, n0 = (it % 96) * 32;
            if (kind == 0) { const int row0 = n0 < 1024 ? n0 : (n0 < 2048 ? 1024 + 256 * ((n0 - 1024) / 128) + ((n0 - 1024) % 128) : 1024 + 256 * ((n0 - 2048) / 128) + 128 + ((n0 - 2048) % 128));
                transpose_item(Win, 1024, 3072, Win_t, row0, kb * 64, n0, scr, lane); }
            else if (n0 < 1024) transpose_item(Win, 1024, 3072, Win_t, n0 & 511, kb * 64, n0, scr, lane, n0 >> 9);
            else transpose_item(Win, 1024, 3072, Win_t, n0 < 2048 ? n0 + 2048 : n0, kb * 64, n0, scr, lane); }
        else if (it < 2048) { const int r = it - 1536; const int kb = r / 32, n0 = (r % 32) * 32; transpose_item(Wout, 1024, 1024, Wout_t, n0, kb * 64, n0, scr, lane); }
        else if (it < 4864) { const int r = it - 2048; const int kb = r / 176, n0 = (r % 176) * 32;
            const int row0 = n0 < 2816 ? 256 * (n0 / 128) + (n0 % 128) : 256 * ((n0 - 2816) / 128) + 128 + ((n0 - 2816) % 128);
            transpose_item(Wf1, 1024, 5632, Wf1_t, row0, kb * 64, n0, scr, lane); }
        else { const int r = it - 4864; const int kb = r / 32, n0 = (r % 32) * 32; transpose_item(Wf2, 2816, 1024, Wf2_t, n0, kb * 64, n0, scr, lane); }
    }
    if (kind == 1) {
        const float* a1 = P.in[I_GA1] + (size_t)j * 2 * 1024 * 16; const float* a2 = P.in[I_GA2] + (size_t)j * 2 * 16 * 512;
        const int gt = ((int)blockIdx.x - c0) * 512 + tid, NT = nblk * 512;
        for (int idx = gt; idx < 1024 * 128; idx += NT) {
            const int row = idx >> 7, kg = idx & 127, dir = row >> 9, d = row & 511;
            float a2v[16];
#pragma unroll
            for (int r = 0; r < 16; ++r) a2v[r] = a2[((size_t)dir * 16 + r) * 512 + d];
            float o[8];
#pragma unroll
            for (int kk = 0; kk < 8; ++kk) { const f32x4* ar = (const f32x4*)(a1 + ((size_t)dir * 1024 + 8 * kg + kk) * 16); float s = 0.f;
#pragma unroll
                for (int q = 0; q < 4; ++q) { const f32x4 av = ar[q]; s += av[0] * a2v[4 * q] + av[1] * a2v[4 * q + 1] + av[2] * a2v[4 * q + 2] + av[3] * a2v[4 * q + 3]; }
                o[kk] = s; }
            u32x4 w; w.x = cvt_pk_bf16(o[0], o[1]); w.y = cvt_pk_bf16(o[2], o[3]); w.z = cvt_pk_bf16(o[4], o[5]); w.w = cvt_pk_bf16(o[6], o[7]);
            *(u32x4*)(Win_t + (size_t)qkl_row(2 + dir, d) * 1024 + 8 * kg) = w;
        }
    }
}

__device__ __forceinline__ void norm_mod_phase(const float* src_lat, const float* src_ctx, const bf16_t* delta, const bf16_t* dparts, float* xo_lat, float* xo_ctx,
                                               const float* gain, const float* modl, int shoff, int scoff, bf16_t* H, int nrows) {
    const int tid = opaque_tid(), wave = tid >> 6, lane = tid & 63;
    const int gw = blockIdx.x * 8 + wave, NGW = gridDim.x * 8;
    for (int r0 = gw * 4; r0 < nrows; r0 += NGW * 4) {
        const float* xrow = r0 < TL ? src_lat + (size_t)r0 * DM : src_ctx + (size_t)(r0 - TL) * DM; const int b = r0 < TL ? (r0 >> 11) : 16;
        float* xout = r0 < TL ? xo_lat + (size_t)r0 * DM : xo_ctx + (size_t)(r0 - TL) * DM;
        f32x4 v[4][4]; float ss[4];
#pragma unroll
        for (int i = 0; i < 4; ++i)
#pragma unroll
            for (int q = 0; q < 4; ++q) v[i][q] = __builtin_nontemporal_load((const f32x4*)(xrow + (size_t)i * DM) + lane + 64 * q);
        if (delta) {
            const int np = (dparts && r0 >= TL) ? 4 : 1;
            for (int p = 0; p < np; ++p) {
                const bf16_t* dsrc = np == 4 ? dparts + (size_t)p * TC * DM + (size_t)(r0 - TL) * DM : delta + (size_t)r0 * DM;
                u32x2 dv[4][4];
#pragma unroll
                for (int i = 0; i < 4; ++i)
#pragma unroll
                    for (int q = 0; q < 4; ++q) dv[i][q] = __builtin_nontemporal_load((const u32x2*)(dsrc + (size_t)i * DM + 4 * lane + 256 * q));
#pragma unroll
                for (int i = 0; i < 4; ++i)
#pragma unroll
                    for (int q = 0; q < 4; ++q) { v[i][q][0] += bf2f((unsigned short)(dv[i][q].x & 0xffff)); v[i][q][1] += bf2f((unsigned short)(dv[i][q].x >> 16));
                        v[i][q][2] += bf2f((unsigned short)(dv[i][q].y & 0xffff)); v[i][q][3] += bf2f((unsigned short)(dv[i][q].y >> 16)); }
            }
        }
#pragma unroll
        for (int i = 0; i < 4; ++i)
#pragma unroll
            for (int q = 0; q < 4; ++q) { if (xo_lat) __builtin_nontemporal_store(v[i][q], (f32x4*)(xout + (size_t)i * DM) + lane + 64 * q); }
        const float* mb = modl + (size_t)b * NADA;
        f32x4 g4[4], sc4[4], sh4[4];
#pragma unroll
        for (int q = 0; q < 4; ++q) { const int col = 4 * lane + 256 * q; g4[q] = *(const f32x4*)(gain + col); sc4[q] = *(const f32x4*)(mb + scoff + col) + 1.0f; sh4[q] = *(const f32x4*)(mb + shoff + col); }
#pragma unroll
        for (int i = 0; i < 4; ++i) { float s = 0.f;
#pragma unroll
            for (int q = 0; q < 4; ++q) s += (v[i][q][0] * v[i][q][0] + v[i][q][1] * v[i][q][1]) + (v[i][q][2] * v[i][q][2] + v[i][q][3] * v[i][q][3]);
            ss[i] = s; }
#pragma unroll
        for (int o = 1; o < 64; o <<= 1) {
#pragma unroll
            for (int i = 0; i < 4; ++i) ss[i] += __shfl_xor(ss[i], o); }
#pragma unroll
        for (int i = 0; i < 4; ++i) { const float rstd = rsqrtf(ss[i] * (1.0f / DM) + 1e-6f);
#pragma unroll
            for (int q = 0; q < 4; ++q) { const int col = 4 * lane + 256 * q; const f32x4 h = (v[i][q] * rstd * g4[q]) * sc4[q] + sh4[q];
                u32x2 w; w.x = cvt_pk_bf16(h[0], h[1]); w.y = cvt_pk_bf16(h[2], h[3]); *(u32x2*)(H + (size_t)(r0 + i) * DM + col) = w; } }
    }
}
__device__ __forceinline__ void final_norm_phase(const float* X, const bf16_t* delta, const float* gain, float* out) {
    const int tid = opaque_tid(), wave = tid >> 6, lane = tid & 63;
    const int gw = blockIdx.x * 8 + wave, NGW = gridDim.x * 8;
    for (int r0 = gw * 4; r0 < TL; r0 += NGW * 4) {
        f32x4 v[4][4]; float ss[4]; u32x2 dv[4][4];
#pragma unroll
        for (int i = 0; i < 4; ++i)
#pragma unroll
            for (int q = 0; q < 4; ++q) { v[i][q] = __builtin_nontemporal_load((const f32x4*)(X + (size_t)(r0 + i) * DM) + lane + 64 * q); dv[i][q] = __builtin_nontemporal_load((const u32x2*)(delta + (size_t)(r0 + i) * DM + 4 * lane + 256 * q)); }
        f32x4 g4[4];
#pragma unroll
        for (int q = 0; q < 4; ++q) g4[q] = *(const f32x4*)(gain + 4 * lane + 256 * q);
#pragma unroll
        for (int i = 0; i < 4; ++i) { float s = 0.f;
#pragma unroll
            for (int q = 0; q < 4; ++q) { v[i][q][0] += bf2f((unsigned short)(dv[i][q].x & 0xffff)); v[i][q][1] += bf2f((unsigned short)(dv[i][q].x >> 16));
                v[i][q][2] += bf2f((unsigned short)(dv[i][q].y & 0xffff)); v[i][q][3] += bf2f((unsigned short)(dv[i][q].y >> 16));
                s += (v[i][q][0] * v[i][q][0] + v[i][q][1] * v[i][q][1]) + (v[i][q][2] * v[i][q][2] + v[i][q][3] * v[i][q][3]); }
            ss[i] = s; }
#pragma unroll
        for (int o = 1; o < 64; o <<= 1) {
#pragma unroll
            for (int i = 0; i < 4; ++i) ss[i] += __shfl_xor(ss[i], o); }
#pragma unroll
        for (int i = 0; i < 4; ++i) { const float rstd = rsqrtf(ss[i] * (1.0f / DM) + 1e-6f);
#pragma unroll
            for (int q = 0; q < 4; ++q) __builtin_nontemporal_store(v[i][q] * rstd * g4[q], (f32x4*)(out + (size_t)(r0 + i) * DM + 4 * lane + 256 * q)); }
    }
}
__device__ __forceinline__ void conv_phase(const bf16_t* PU, const float* cw, bf16_t* Z, int ntok) {
    const int gt = blockIdx.x * 512 + opaque_tid(), NT = gridDim.x * 512;
    const int total = (ntok >> 3) * 128;
    for (int idx = gt; idx < total; idx += NT) {
        const int t0 = (idx >> 7) * 8, cg8 = (idx & 127) * 8;
        int pos0, len; if (t0 < TL) { pos0 = t0 & 63; len = 64; } else { pos0 = (t0 - TL) & 255; len = 256; }
        const bf16_t* row = PU + (size_t)t0 * 2048 + cg8;
        const bool hasp = pos0 > 0, hasn = pos0 + 8 < len;
        u32x4 gbv[8], uv[10];
        const u32x4 z4 = (u32x4){0, 0, 0, 0};
        uv[0] = z4; uv[9] = z4;
        if (hasp) uv[0] = __builtin_nontemporal_load((const u32x4*)(row - 2048 + 1024));
#pragma unroll
        for (int i = 0; i < 8; ++i) { gbv[i] = __builtin_nontemporal_load((const u32x4*)(row + (size_t)i * 2048)); uv[i + 1] = __builtin_nontemporal_load((const u32x4*)(row + (size_t)i * 2048 + 1024)); }
        if (hasn) uv[9] = __builtin_nontemporal_load((const u32x4*)(row + (size_t)8 * 2048 + 1024));
        float w0[8], w1[8], w2[8];
#pragma unroll
        for (int e = 0; e < 8; ++e) { w0[e] = cw[cg8 + e]; w1[e] = cw[1024 + cg8 + e]; w2[e] = cw[2048 + cg8 + e]; }
#pragma unroll
        for (int i = 0; i < 8; ++i) {
            float o[8];
#pragma unroll
            for (int q = 0; q < 4; ++q) {
                const float gb0 = bf2f((unsigned short)(gbv[i][q] & 0xffff)), gb1 = bf2f((unsigned short)(gbv[i][q] >> 16));
                const float p0 = bf2f((unsigned short)(uv[i][q] & 0xffff)), p1 = bf2f((unsigned short)(uv[i][q] >> 16));
                const float c0 = bf2f((unsigned short)(uv[i + 1][q] & 0xffff)), c1 = bf2f((unsigned short)(uv[i + 1][q] >> 16));
                const float n0 = bf2f((unsigned short)(uv[i + 2][q] & 0xffff)), n1 = bf2f((unsigned short)(uv[i + 2][q] >> 16));
                o[2 * q] = gb0 * (w0[2 * q] * p0 + w1[2 * q] * c0 + w2[2 * q] * n0);
                o[2 * q + 1] = gb1 * (w0[2 * q + 1] * p1 + w1[2 * q + 1] * c1 + w2[2 * q + 1] * n1); }
            u32x4 w; w.x = cvt_pk_bf16(o[0], o[1]); w.y = cvt_pk_bf16(o[2], o[3]); w.z = cvt_pk_bf16(o[4], o[5]); w.w = cvt_pk_bf16(o[6], o[7]);
            *(u32x4*)(Z + (size_t)(t0 + i) * DM + cg8) = w;
        }
    }
}
__device__ __forceinline__ void gla_out_phase(const bf16_t* Of, const bf16_t* Ob, const bf16_t* R, const float* ng, bf16_t* G, int ntok) {
    const int tid = opaque_tid(), wave = tid >> 6, lane = tid & 63;
    const int gw = blockIdx.x * 8 + wave, NGW = gridDim.x * 8;
    const float* ngp = ng + ((16 * lane) & 255);
    float ngv[16];
#pragma unroll
    for (int e = 0; e < 16; ++e) ngv[e] = ngp[e];
    for (int t0 = gw * 2; t0 < ntok; t0 += NGW * 2) {
        u32x4 av[2][2], bv[2][2], rv[2][2];
#pragma unroll
        for (int i = 0; i < 2; ++i) { const size_t off = (size_t)(t0 + i) * DM + 16 * lane;
            av[i][0] = __builtin_nontemporal_load((const u32x4*)(Of + off)); av[i][1] = __builtin_nontemporal_load((const u32x4*)(Of + off + 8)); bv[i][0] = __builtin_nontemporal_load((const u32x4*)(Ob + off)); bv[i][1] = __builtin_nontemporal_load((const u32x4*)(Ob + off + 8));
            rv[i][0] = __builtin_nontemporal_load((const u32x4*)(R + off)); rv[i][1] = __builtin_nontemporal_load((const u32x4*)(R + off + 8)); }
#pragma unroll
        for (int i = 0; i < 2; ++i) {
            float o[16]; float s = 0.f;
#pragma unroll
            for (int hh = 0; hh < 2; ++hh)
#pragma unroll
                for (int q = 0; q < 4; ++q) {
                    o[8 * hh + 2 * q] = bf2f((unsigned short)(av[i][hh][q] & 0xffff)) + bf2f((unsigned short)(bv[i][hh][q] & 0xffff));
                    o[8 * hh + 2 * q + 1] = bf2f((unsigned short)(av[i][hh][q] >> 16)) + bf2f((unsigned short)(bv[i][hh][q] >> 16)); }
#pragma unroll
            for (int e = 0; e < 16; ++e) s += o[e] * o[e];
            s += __shfl_xor(s, 1); s += __shfl_xor(s, 2); s += __shfl_xor(s, 4); s += __shfl_xor(s, 8);
            const float rstd = rsqrtf(s * (1.0f / 256.0f) + 1e-6f);
            float y[16];
#pragma unroll
            for (int hh = 0; hh < 2; ++hh)
#pragma unroll
                for (int q = 0; q < 4; ++q) {
                    y[8 * hh + 2 * q] = o[8 * hh + 2 * q] * rstd * ngv[8 * hh + 2 * q] * bf2f((unsigned short)(rv[i][hh][q] & 0xffff));
                    y[8 * hh + 2 * q + 1] = o[8 * hh + 2 * q + 1] * rstd * ngv[8 * hh + 2 * q + 1] * bf2f((unsigned short)(rv[i][hh][q] >> 16)); }
            u32x4 w0, w1;
            w0.x = cvt_pk_bf16(y[0], y[1]); w0.y = cvt_pk_bf16(y[2], y[3]); w0.z = cvt_pk_bf16(y[4], y[5]); w0.w = cvt_pk_bf16(y[6], y[7]);
            w1.x = cvt_pk_bf16(y[8], y[9]); w1.y = cvt_pk_bf16(y[10], y[11]); w1.z = cvt_pk_bf16(y[12], y[13]); w1.w = cvt_pk_bf16(y[14], y[15]);
            const size_t off = (size_t)(t0 + i) * DM + 16 * lane;
            *(u32x4*)(G + off) = w0; *(u32x4*)(G + off + 8) = w1;
        }
    }
}

constexpr int SC_QD = 0, SC_KI = 18432, SC_KDT = 36864, SC_VT = 57344, SC_ST = 77824, SC_P = 114688, SC_TOT = 124928, SC_DEC = 124928, SC_LA = 125440, SC_ET = 125440  ;
constexpr int PQ = 144, PS = 80;
__device__ __forceinline__ void gla_scan_phase(LAS unsigned char* lds, const bf16_t* QDf, const bf16_t* KIf, const bf16_t* QDb, const bf16_t* KIb, const float* ET, const bf16_t* VT, bf16_t* Of, bf16_t* Ob) {
    const int tid = opaque_tid(), w = __builtin_amdgcn_readfirstlane(tid >> 6), lane = tid & 63, fr = lane & 15, fq = lane >> 4;
    LAS bf16_t* QD = (LAS bf16_t*)(lds + SC_QD); LAS bf16_t* KI = (LAS bf16_t*)(lds + SC_KI); LAS bf16_t* KDT = (LAS bf16_t*)(lds + SC_KDT);
    LAS bf16_t* VTs = (LAS bf16_t*)(lds + SC_VT); LAS bf16_t* ST = (LAS bf16_t*)(lds + SC_ST); LAS bf16_t* Pm = (LAS bf16_t*)(lds + SC_P);
    LAS float* TOT = (LAS float*)(lds + SC_TOT); LAS float* DEC = (LAS float*)(lds + SC_DEC);
    const int d = tid & 127, seg = tid >> 7;
    for (int item = blockIdx.x; item < 256; item += gridDim.x) {
        const int es = item & 1, dir = (item >> 1) & 1, h = (item >> 2) & 3, b = item >> 4;
        bf16_t* Od = dir ? Ob : Of;
        for (int i = tid; i < 128 * PQ / 2; i += 512) ((LAS unsigned*)ST)[i] = 0u;
#define SCAN_TOK0(st) ((st) < 4 ? (TL + b * 256 + (dir ? 3 - (st) : (st)) * 64) : (b * 2048 + (dir ? 31 - ((st) - 4) : ((st) - 4)) * 64))
        LAS float* ETL = (LAS float*)(lds + SC_ET);
        for (int i = tid; i < 36 * 128; i += 512) { const int st = i >> 7, dd = i & 127; const int t0_ = SCAN_TOK0(st); ETL[i] = ET[((size_t)(t0_ >> 6) * 2 + dir) * 512 + h * 128 + dd]; }
        f32x4 S[8];
#pragma unroll
        for (int dt = 0; dt < 8; ++dt) S[dt] = (f32x4){0.f, 0.f, 0.f, 0.f};
        __syncthreads();
        const bf16_t* QDg = dir ? QDb : QDf; const bf16_t* KIg = dir ? KIb : KIf;
        u32x4 qv[2][2], kv[2][2], vtv[2][2];
        const int krow = tid & 63, kc8 = (tid >> 6) * 8;
#define SCAN_LOAD(st, S) do { const int _t0 = SCAN_TOK0(st); \
            _Pragma("unroll") for (int i = 0; i < 2; ++i) { const int piece = tid + 512 * i; const int row = piece >> 4, c8 = (piece & 15) * 8; \
                qv[S][i] = *(const u32x4*)(QDg + (size_t)(_t0 + row) * 512 + h * 128 + c8); \
                kv[S][i] = *(const u32x4*)(KIg + (size_t)(_t0 + krow) * 512 + h * 128 + kc8 + 64 * i); \
                const int er = piece >> 3, pc = piece & 7; vtv[S][i] = *(const u32x4*)(VT + (size_t)(h * 256 + es * 128 + er) * TT + _t0 + 8 * pc); } } while (0)
        SCAN_LOAD(0, 0); SCAN_LOAD(1, 1);
        for (int step2 = 0; step2 < 36; step2 += 2) {
#pragma unroll
          for (int ss = 0; ss < 2; ++ss) {
            const int step = step2 + ss;
            const int tok0 = SCAN_TOK0(step);
#pragma unroll
            for (int i = 0; i < 2; ++i) { const int piece = tid + 512 * i; const int row = piece >> 4, c8 = (piece & 15) * 8;
                *(LAS u32x4*)(QD + row * PQ + c8) = qv[ss][i];
                *(LAS u32x4*)(KI + krow * PQ + kc8 + 64 * i) = kv[ss][i];
                const f32x4 e0 = *(const LAS f32x4*)(ETL + step * 128 + kc8 + 64 * i), e1 = *(const LAS f32x4*)(ETL + step * 128 + kc8 + 64 * i + 4);
#pragma unroll
                for (int q = 0; q < 4; ++q) { const float klo = bf2f((unsigned short)(kv[ss][i][q] & 0xffff)), khi = bf2f((unsigned short)(kv[ss][i][q] >> 16));
                    const float elo = (2 * q < 4) ? e0[(2 * q) & 3] : e1[(2 * q) & 3], ehi = (2 * q + 1 < 4) ? e0[(2 * q + 1) & 3] : e1[(2 * q + 1) & 3];
                    KDT[(kc8 + 64 * i + 2 * q) * PS + krow] = f2bf(klo * elo); KDT[(kc8 + 64 * i + 2 * q + 1) * PS + krow] = f2bf(khi * ehi); }
                const int er = piece >> 3, pc = piece & 7; *(LAS u32x4*)(VTs + er * PS + 8 * pc) = vtv[ss][i]; }
            __syncthreads();
            if (step + 2 < 36) SCAN_LOAD(step + 2, ss);
#define FRAG(base, row, pitch, ks) (*(const LAS bf16x8*)((base) + (row) * (pitch) + (ks) * 32 + fq * 8))
            {
                const int id0 = 2 * w, ct0 = id0 >> 2, st0 = id0 & 3, st1 = st0 + 1;
                bf16x8 qa[4], kb0[4], kb1[4];
#pragma unroll
                for (int ks = 0; ks < 4; ++ks) { qa[ks] = FRAG(QD, ct0 * 16 + fr, PQ, ks); kb0[ks] = FRAG(KI, st0 * 16 + fr, PQ, ks); kb1[ks] = FRAG(KI, st1 * 16 + fr, PQ, ks); }
                bf16x8 sa[4];
#pragma unroll
                for (int ks = 0; ks < 4; ++ks) sa[ks] = FRAG(ST, 16 * w + fr, PQ, ks);
#pragma unroll
                for (int dt = 0; dt < 8; ++dt) { const f32x4 dcv = *(const LAS f32x4*)(ETL + step * 128 + 16 * dt + 4 * fq); S[dt] = S[dt] * dcv; }
                __builtin_amdgcn_sched_barrier(0);
                f32x4 a0 = (f32x4){0.f, 0.f, 0.f, 0.f}, a1 = a0;
#pragma unroll
                for (int ks = 0; ks < 4; ++ks) { a0 = __builtin_amdgcn_mfma_f32_16x16x32_bf16(qa[ks], kb0[ks], a0, 0, 0, 0); a1 = __builtin_amdgcn_mfma_f32_16x16x32_bf16(qa[ks], kb1[ks], a1, 0, 0, 0); }
#pragma unroll
                for (int rg = 0; rg < 4; ++rg) { const int c_ = ct0 * 16 + 4 * fq + rg; const int s0_ = st0 * 16 + fr, s1_ = st1 * 16 + fr;
                    const bool k0_ = dir == 0 ? (s0_ <= c_) : (s0_ >= c_), k1_ = dir == 0 ? (s1_ <= c_) : (s1_ >= c_);
                    Pm[c_ * PS + s0_] = k0_ ? f2bf(a0[rg]) : (bf16_t)0; Pm[c_ * PS + s1_] = k1_ ? f2bf(a1[rg]) : (bf16_t)0; }
                f32x4 oacc[4];
#pragma unroll
                for (int ct = 0; ct < 4; ++ct) oacc[ct] = (f32x4){0.f, 0.f, 0.f, 0.f};
#pragma unroll
                for (int ct = 0; ct < 4; ++ct) {
                    bf16x8 qb[4];
#pragma unroll
                    for (int ks = 0; ks < 4; ++ks) qb[ks] = FRAG(QD, 16 * ct + fr, PQ, ks);
#pragma unroll
                    for (int ks = 0; ks < 4; ++ks) oacc[ct] = __builtin_amdgcn_mfma_f32_16x16x32_bf16(sa[ks], qb[ks], oacc[ct], 0, 0, 0);
                }
                __syncthreads();
                bf16x8 va[2], pb[4][2];
#pragma unroll
                for (int ks = 0; ks < 2; ++ks) { va[ks] = FRAG(VTs, 16 * w + fr, PS, ks);
#pragma unroll
                    for (int ct = 0; ct < 4; ++ct) pb[ct][ks] = FRAG(Pm, 16 * ct + fr, PS, ks); }
                __builtin_amdgcn_sched_barrier(0);
#pragma unroll
                for (int ks = 0; ks < 2; ++ks)
#pragma unroll
                    for (int ct = 0; ct < 4; ++ct) oacc[ct] = __builtin_amdgcn_mfma_f32_16x16x32_bf16(va[ks], pb[ct][ks], oacc[ct], 0, 0, 0);
#pragma unroll
                for (int ct = 0; ct < 4; ++ct) { u32x2 wv; wv.x = cvt_pk_bf16(oacc[ct][0], oacc[ct][1]); wv.y = cvt_pk_bf16(oacc[ct][2], oacc[ct][3]);
                    *(u32x2*)(Od + (size_t)(tok0 + 16 * ct + fr) * DM + h * 256 + es * 128 + 16 * w + 4 * fq) = wv; }
#pragma unroll
                for (int half = 0; half < 2; ++half) {
                    bf16x8 ka[4][2];
#pragma unroll
                    for (int dd = 0; dd < 4; ++dd)
#pragma unroll
                        for (int ks = 0; ks < 2; ++ks) ka[dd][ks] = FRAG(KDT, 16 * (4 * half + dd) + fr, PS, ks);
                    __builtin_amdgcn_sched_barrier(0);
#pragma unroll
                    for (int ks = 0; ks < 2; ++ks)
#pragma unroll
                        for (int dd = 0; dd < 4; ++dd) S[4 * half + dd] = __builtin_amdgcn_mfma_f32_16x16x32_bf16(ka[dd][ks], va[ks], S[4 * half + dd], 0, 0, 0);
                }
#pragma unroll
                for (int dt = 0; dt < 8; ++dt) { u32x2 wv; wv.x = cvt_pk_bf16(S[dt][0], S[dt][1]); wv.y = cvt_pk_bf16(S[dt][2], S[dt][3]); *(LAS u32x2*)(ST + (16 * w + fr) * PQ + 16 * dt + 4 * fq) = wv; }
            }
#undef FRAG
            __syncthreads();
          }
        }
    }
}

#undef SCAN_LOAD
#undef SCAN_TOK0
__global__ void __launch_bounds__(512, 2) fwd_megakernel(Params P) {
    extern __shared__ __attribute__((aligned(16))) unsigned char lds_raw[];
    LAS unsigned char* lds = (LAS unsigned char*)lds_raw;
    cg::grid_group grid = cg::this_grid();
#define GSYNC0() do { asm volatile("s_waitcnt vmcnt(0) lgkmcnt(0)" ::: "memory"); __syncthreads(); grid.sync(); asm volatile("s_waitcnt vmcnt(0) lgkmcnt(0)" ::: "memory"); __syncthreads(); } while (0)
    volatile LAS unsigned* xb_st = (volatile LAS unsigned*)(lds + LDS_BYTES - 16);
    if (threadIdx.x == 0) { xb_st[0] = 0u; xb_st[1] = 0u; }
    __syncthreads();
    const XcdBarrier xbar = xcd_barrier_post((unsigned*)(P.ws + WS_CTL), xb_st);
    grid.sync();
#define GSYNC() xcd_barrier(xbar)
    const int G = gridDim.x, bx = blockIdx.x;
    unsigned char* ws = P.ws;
    float* mod = (float*)(ws + WS_MOD);
    float* Xl = P.out; float* Xc = (float*)(ws + WS_XCTX);
    bf16_t* HZ = (bf16_t*)(ws + WS_HZ); bf16_t* BIG = (bf16_t*)(ws + WS_BIG);
    bf16_t* QDf = (bf16_t*)(ws + WS_BIG); bf16_t* KIf = (bf16_t*)(ws + WS_BIG + 36 * MiB); bf16_t* QDb = (bf16_t*)(ws + WS_BIG + 72 * MiB); bf16_t* KIb = (bf16_t*)(ws + WS_BIG + 108 * MiB); bf16_t* VTb = (bf16_t*)(ws + WS_BIG + BIG_VT);
    float* ETb = (float*)(ws + WS_ET);
    bf16_t* Rb = (bf16_t*)(ws + WS_R); bf16_t* Obb = (bf16_t*)(ws + WS_OB);
    bf16_t* Dpb = (bf16_t*)(ws + WS_OB);
    bf16_t* Db = (bf16_t*)(ws + WS_R);

#ifndef NO_ADA
    ada_phase(lds, P);
#endif
    GSYNC();
#pragma unroll 1
    for (int layer = 0; layer < 4; ++layer) {
        const int kind = layer & 1, j = layer >> 1; const bool last = layer == 3;
        const float* modl = mod + (size_t)layer * NCOND * NADA;
        const float* src_lat = layer == 0 ? P.in[I_X] : Xl; const float* src_ctx = layer == 0 ? P.in[I_CTX] : Xc;
        const int Mall = TT, Mres = last ? TL : TT;
        unsigned char* wb = ws + ((layer & 1) ? WS_W2 : 0);
        bf16_t* Win_t = (bf16_t*)(wb + WS_WIN); bf16_t* Wout_t = (bf16_t*)(wb + WS_WOUT); bf16_t* Wf1_t = (bf16_t*)(wb + WS_WF1); bf16_t* Wf2_t = (bf16_t*)(wb + WS_WF2);
#ifndef NO_PREP
        prep_layer(lds, P, layer, 0, G);
#endif
        norm_mod_phase(src_lat, src_ctx, layer == 0 ? (const bf16_t*)nullptr : Db, Dpb, layer == 0 ? (float*)nullptr : Xl, Xc, P.in[I_N1G] + layer * DM, modl, 0, 1024, HZ, Mall);
        GSYNC();
        if (kind == 1) {
            pg8::Gemm g{HZ, Win_t, Mall, 3072, 1024}; pg8::StaticOrder S; S.init(Mall, 3072, 1024, G, bx);
            EpiGla E{QDf, KIf, QDb, KIb, Rb, ETb, P.in[I_GBR] + j * 1024, P.in[I_GBA] + j * 1024};
#ifndef NO_GGLA
            pg8::gemm_phase<EpiGla>(lds, g, S, E);
#endif
        }
        if (kind == 0) {
            pg8::Gemm g{HZ, Win_t, Mall, 3072, 1024}; pg8::StaticOrder S; S.init(Mall, 3072, 1024, G, bx);
            EpiConvIn E{BIG};
#ifndef NO_GPLAIN
            pg8::gemm_phase<EpiConvIn>(lds, g, S, E);
#endif
        } else {
            pg8::Gemm g{Win_t + (size_t)3072 * 1024, HZ, 1024, Mall, 1024}; pg8::StaticOrder S; S.init(1024, Mall, 1024, G, (bx + 64) % G);
            EpiPlain E{VTb, (size_t)TT};
#ifndef NO_GPLAIN
            pg8::gemm_phase<EpiPlain>(lds, g, S, E);
#endif
        }
        GSYNC();
        const bf16_t* Aout;
        if (kind == 0) {
            conv_phase(BIG, P.in[I_CW] + j * 3 * 1024, HZ, Mres);
            Aout = HZ;
        } else {
#ifndef NO_SCAN
            gla_scan_phase(lds, QDf, KIf, QDb, KIb, ETb, VTb, HZ, Obb);
#endif
            GSYNC();
            gla_out_phase(HZ, Obb, Rb, P.in[I_GNG] + j * 256, BIG, Mres);
            Aout = BIG;
        }
        GSYNC();
        {
            pg8::Gemm g{Aout, Wout_t, Mres, 1024, 1024};
            EpiDelta E{Db, modl + 2048, Dpb, last ? 0 : 1};
#ifndef NO_GRES
            if (last) { pg8::StaticOrder S; S.init(Mres, 1024, 1024, G, bx); pg8::gemm_phase<EpiDelta>(lds, g, S, E); }
            else { pg8::TailOrder S; S.init(1024, 1024, G, bx); pg8::gemm_phase<EpiDelta, pg8::TailOrder>(lds, g, S, E); }
#endif
        }
        GSYNC();
        norm_mod_phase(src_lat, src_ctx, Db, last ? (const bf16_t*)nullptr : Dpb, Xl, Xc, P.in[I_N2G] + layer * DM, modl, 3072, 4096, HZ, Mres);
        GSYNC();
        {
            pg8::Gemm g{HZ, Wf1_t, Mres, 5632, 1024}; pg8::StaticOrder S; S.init(Mres, 5632, 1024, G, bx);
            EpiSwiglu E{BIG};
#ifndef NO_GSWI
            pg8::gemm_phase<EpiSwiglu>(lds, g, S, E);
#endif
        }
        GSYNC();
        {
            pg8::Gemm g{BIG, Wf2_t, Mres, 1024, 2816};
            EpiDelta E{Db, modl + 5120, Dpb, last ? 0 : 1};
#ifndef NO_GRES
            if (last) { pg8::StaticOrder S; S.init(Mres, 1024, 2816, G, bx); pg8::gemm_phase<EpiDelta>(lds, g, S, E); }
            else { pg8::TailOrder S; S.init(1024, 2816, G, bx); pg8::gemm_phase<EpiDelta, pg8::TailOrder>(lds, g, S, E); }
#endif
        }
        GSYNC();
    }
    final_norm_phase(Xl, Db, P.in[I_FG], P.out);
}

extern "C" void kernel_launch(void* const* d_in, const int* in_sizes, int n_in, void* d_out, int out_size, void* d_ws, size_t ws_size, hipStream_t stream) {
    static int grid_blocks = 0;
    if (grid_blocks == 0) {
        if (n_in != 21 || ws_size < WS_END) { fprintf(stderr, "kernel_launch: unexpected n_in %d / ws_size %zu (need %zu)\n", n_in, ws_size, (size_t)WS_END); grid_blocks = -1; return; }
        int dev = 0, cus = 0, per_cu = 0;
        hipGetDevice(&dev);
        hipDeviceGetAttribute(&cus, hipDeviceAttributeMultiprocessorCount, dev);
        if (hipFuncSetAttribute((const void*)fwd_megakernel, hipFuncAttributeMaxDynamicSharedMemorySize, LDS_BYTES) != hipSuccess) { fprintf(stderr, "kernel_launch: hipFuncSetAttribute failed\n"); grid_blocks = -1; return; }
        if (hipOccupancyMaxActiveBlocksPerMultiprocessor(&per_cu, (const void*)fwd_megakernel, 512, LDS_BYTES) != hipSuccess || per_cu < 1) { fprintf(stderr, "kernel_launch: occupancy query says %d\n", per_cu); per_cu = 1; }
        (void)hipGetLastError();
        grid_blocks = cus;
    }
    if (grid_blocks < 0) return;
    if (hipMemsetAsync((char*)d_ws + WS_CTL, 0, XCD_BAR_WORDS * 4, stream) != hipSuccess) { fprintf(stderr, "kernel_launch: memset of the barrier words failed\n"); return; }
    Params p{};
    for (int i = 0; i < 21; ++i) p.in[i] = (const float*)d_in[i];
    p.out = (float*)d_out; p.ws = (unsigned char*)d_ws;
    void* args[] = {&p};
    hipError_t e = hipLaunchCooperativeKernel((const void*)fwd_megakernel, dim3(grid_blocks), dim3(512), args, LDS_BYTES, stream);
    if (e != hipSuccess) fprintf(stderr, "cooperative launch failed: %s (grid %d)\n", hipGetErrorString(e), grid_blocks);
}
```

```cpp
#include <hip/hip_runtime.h>
#include <hip/hip_cooperative_groups.h>
#include <cstdio>
#include <cstdint>
namespace cg = cooperative_groups;

#define LAS __attribute__((address_space(3)))
typedef unsigned short bf16_t;
typedef short bf16x8 __attribute__((ext_vector_type(8)));
typedef float f32x4 __attribute__((ext_vector_type(4)));
typedef float f32x2 __attribute__((ext_vector_type(2)));
typedef unsigned u32x4 __attribute__((ext_vector_type(4)));
typedef unsigned u32x2 __attribute__((ext_vector_type(2)));

constexpr int DM = 1024, TL = 32768, TC = 4096, TT = TL + TC, DFF = 2816, NCOND = 17, NADA = 6144;
constexpr int LDS_BYTES = 147456;
constexpr size_t MiB = 1u << 20;
constexpr size_t WS_WIN = 0, WS_WOUT = 8 * MiB, WS_WF1 = 10 * MiB, WS_WF2 = 21 * MiB, WS_MOD = 27 * MiB, WS_XCTX = 29 * MiB,
                 WS_HZ = 45 * MiB, WS_BIG = 117 * MiB, WS_R = 333 * MiB, WS_OB = 405 * MiB, WS_W2 = 477 * MiB  , WS_CTL = 504 * MiB, WS_ET = 505 * MiB  , WS_END = 508 * MiB;
constexpr size_t BIG_Q = 0, BIG_K = 36 * MiB, BIG_LA = 72 * MiB, BIG_VT = 144 * MiB;

struct Params { const float* in[21]; float* out; unsigned char* ws; };
enum { I_X = 0, I_C, I_CTX, I_CCTX, I_ADAW, I_ADAB, I_N1G, I_N2G, I_CWIN, I_CW, I_CWOUT, I_GWIN, I_GBR, I_GA1, I_GA2, I_GBA, I_GNG, I_GWOUT, I_FWIN, I_FWOUT, I_FG };

typedef __bf16 bf16x2v __attribute__((ext_vector_type(2)));
__device__ __forceinline__ unsigned cvt_pk_bf16(float lo, float hi) { f32x2 v = {lo, hi}; bf16x2v b = __builtin_convertvector(v, bf16x2v); return __builtin_bit_cast(unsigned, b); }
__device__ __forceinline__ float bf2f(unsigned short b) { return __uint_as_float(((unsigned)b) << 16); }
__device__ __forceinline__ unsigned short f2bf(float f) { return (unsigned short)(cvt_pk_bf16(f, 0.f) & 0xffffu); }
__device__ __forceinline__ float silu_f(float v) { return v * __builtin_amdgcn_rcpf(1.0f + __expf(-v)); }
__device__ __forceinline__ float wave_sum(float v) {
#pragma unroll
    for (int o = 1; o < 64; o <<= 1) v += __shfl_xor(v, o);
    return v;
}
__device__ __forceinline__ int opaque_tid() { int t = threadIdx.x; asm volatile("" : "+v"(t)); return t; }

__device__ __forceinline__ void grid_bar(unsigned* ctr, unsigned target) {
    asm volatile("s_waitcnt vmcnt(0) lgkmcnt(0)" ::: "memory");
    __syncthreads();
    if (threadIdx.x == 0) {
        __builtin_amdgcn_fence(__ATOMIC_RELEASE, "agent");
        asm volatile("s_waitcnt vmcnt(0)" ::: "memory");
        __hip_atomic_fetch_add(ctr, 1u, __ATOMIC_RELAXED, __HIP_MEMORY_SCOPE_AGENT);
        __builtin_amdgcn_fence(__ATOMIC_ACQUIRE, "agent");
        unsigned polls = 0; const unsigned long long t0 = __builtin_amdgcn_s_memrealtime();
        while ((int)(__hip_atomic_load(ctr, __ATOMIC_RELAXED, __HIP_MEMORY_SCOPE_AGENT) - target) < 0) {
            __builtin_amdgcn_s_sleep(1);
            if ((++polls & 255u) == 0u && __builtin_amdgcn_s_memrealtime() - t0 > 200000000ull) break;
        }
        asm volatile("s_waitcnt vmcnt(0)" ::: "memory");
    }
    __syncthreads();
}

#define XB_TMO      128
#define XB_XCNT(j)  (256  + 64 * (j))
#define XB_XSUB(j)  (1280 + 64 * (j))
#define XB_XGEN(j)  (2304 + 64 * (j))
#define XB_TOP      3328
#define XB_TOPGEN   3392
#define XCD_BAR_WORDS 3456
#define XB_SPIN_CAP (1u << 18)
__device__ __forceinline__ unsigned xb_ld(unsigned* p)              { return __hip_atomic_load(p, __ATOMIC_RELAXED, __HIP_MEMORY_SCOPE_AGENT); }
__device__ __forceinline__ unsigned xb_add(unsigned* p, unsigned v) { return __hip_atomic_fetch_add(p, v, __ATOMIC_RELAXED, __HIP_MEMORY_SCOPE_AGENT); }
__device__ __forceinline__ unsigned xb_xcc_id() { return (unsigned)__builtin_amdgcn_s_getreg((3 << 11) | 20) & 0xFu; }
#define XB_SPIN(cond, bar) do { unsigned _sp = 0; while (cond) { __builtin_amdgcn_s_sleep(1); \
    if ((++_sp & 255u) == 0u) { if (xb_ld(&(bar)[XB_TMO])) break; if (_sp > XB_SPIN_CAP) { atomicAdd(&(bar)[XB_TMO], 1u); break; } } } } while (0)
struct XcdBarrier { unsigned* bar; unsigned x; volatile LAS unsigned* st; };
__device__ __forceinline__ XcdBarrier xcd_barrier_post(unsigned* bar, volatile LAS unsigned* st) {
    XcdBarrier b; b.bar = bar; b.x = xb_xcc_id(); b.st = st;
    if (threadIdx.x == 0) (void)xb_add(&bar[XB_XCNT(b.x)], 1u);
    return b;
}
__device__ __forceinline__ void xcd_barrier_complete(unsigned* bar, unsigned x, unsigned& nloc, unsigned& nx) {
    const unsigned G = gridDim.x * gridDim.y * gridDim.z;
    unsigned sum, cnt, mine, sp = 0u;
    for (;;) {
        sum = 0u; cnt = 0u; mine = 0u;
#pragma unroll
        for (unsigned j = 0; j < 16; ++j) { const unsigned c = xb_ld(&bar[XB_XCNT(j)]); sum += c; cnt += (c > 0u) ? 1u : 0u; mine = (j == x) ? c : mine; }
        if (sum == G) break;
        __builtin_amdgcn_s_sleep(1);
        if ((++sp & 255u) == 0u) { if (xb_ld(&bar[XB_TMO])) break; if (sp > XB_SPIN_CAP) { atomicAdd(&bar[XB_TMO], 1u); break; } }
    }
    nloc = mine > 0u ? mine : 1u; nx = cnt > 0u ? cnt : 1u;
}
__device__ __forceinline__ void xcd_barrier(const XcdBarrier& b) {
    asm volatile("s_waitcnt vmcnt(0) lgkmcnt(0)" ::: "memory");
    __syncthreads();
    if (threadIdx.x == 0) {
        unsigned* bar = b.bar;
        __builtin_amdgcn_s_waitcnt(0);
        unsigned nloc = b.st[0], nx = b.st[1];
        if (nloc == 0u) { xcd_barrier_complete(bar, b.x, nloc, nx); b.st[0] = nloc; b.st[1] = nx; }
        const unsigned old = xb_add(&bar[XB_XSUB(b.x)], 1u);
        const unsigned gen = old / nloc;
        if (old + 1u == (gen + 1u) * nloc) {
            __builtin_amdgcn_fence(__ATOMIC_RELEASE, "agent");
            asm volatile("s_waitcnt vmcnt(0)" ::: "memory");
            const unsigned og = xb_add(&bar[XB_TOP], 1u);
            const unsigned tg = og / nx;
            __builtin_amdgcn_fence(__ATOMIC_ACQUIRE, "agent");
            if (og + 1u == (tg + 1u) * nx) xb_add(&bar[XB_TOPGEN], 1u);
            else XB_SPIN(xb_ld(&bar[XB_TOPGEN]) == tg, bar);
            xb_add(&bar[XB_XGEN(b.x)], 1u);
            asm volatile("s_waitcnt vmcnt(0)" ::: "memory");
        } else {
            __builtin_amdgcn_fence(__ATOMIC_ACQUIRE, "agent");
            XB_SPIN(xb_ld(&bar[XB_XGEN(b.x)]) == gen, bar);
            asm volatile("s_waitcnt vmcnt(0)" ::: "memory");
        }
    }
    __syncthreads();
}
#define LDS_WAIT() asm volatile("s_waitcnt lgkmcnt(0)" ::: "memory")

namespace pg8 {
constexpr int BM = 256, BK = 64, HALF = 128, HTB = HALF * BK * 2, STAGE_BYTES = 8 * HTB, NXCD = 8, WGM = 8;
__host__ __device__ __forceinline__ int lds_byte(int r, int c) { const int st = (r >> 4) * 2 + (c >> 5), rr = r & 15, cc = c & 31, ob = rr * 64 + cc * 2; return st * 1024 + (ob ^ (((ob >> 9) & 1) << 5)); }
__host__ __device__ __forceinline__ void stage_rc(int b, int& R, int& C) { const int st = b / 1024, sb = b % 1024, swz = sb ^ (((sb >> 9) & 1) << 5); R = (st >> 1) * 16 + swz / 64; C = (st & 1) * 32 + (swz % 64) / 2; }

__host__ __device__ __forceinline__ int perm32(int rho) { const int n = rho >> 4, i = rho & 15; return 8 * (i >> 2) + 4 * n + (i & 3); }
struct Unit { int pm, pn, k0, nt, part; };
struct Gemm { const bf16_t* A; const bf16_t* Bt; int M, N, K; };

struct StaticOrder {
    int nM, nN, nwg, G, c, ktiles;
    __host__ __device__ void init(int M, int N, int K, int G_, int c_) { nM = M / BM; nN = N / BM; nwg = nM * nN; G = G_; c = c_; ktiles = K / BK; }
    __host__ __device__ __forceinline__ int map(int L) const {
        int wgid = L; { const int q = nwg / NXCD, r = nwg % NXCD, xcd = wgid % NXCD, off = wgid / NXCD; wgid = (xcd < r ? xcd * (q + 1) : r * (q + 1) + (xcd - r) * q) + off; }
        const int nig = WGM * nN, gid = wgid / nig, fm = gid * WGM, gsz = (nM - fm) < WGM ? (nM - fm) : WGM;
        return ((fm + ((wgid % nig) % gsz)) << 16) | ((wgid % nig) / gsz);
    }
    __host__ __device__ __forceinline__ bool next(int i, Unit& u) const {
        const long L = (long)i * G + c; if (L >= nwg) return false;
        const int pp = map((int)L); Unit t; t.pm = pp >> 16; t.pn = pp & 0xffff; t.k0 = 0; t.nt = ktiles; t.part = 0; u = t; return true;
    }
};
struct TailOrder {
    StaticOrder lat; int q, r;
    __host__ __device__ void init(int N, int K, int G_, int c_) { lat.init(TL, N, K, G_, c_); const int kt = K / BK; q = (kt / 4) & ~1; r = kt - 4 * q; }
    __host__ __device__ __forceinline__ bool next(int i, Unit& u) const {
        const long L = (long)i * lat.G + lat.c;
        const int s = (int)(L - lat.nwg); if (s >= 64 * 4) return false;
        const bool whole = L < lat.nwg;
        const int pp = lat.map(whole ? (int)L : 0);
        const int part = s & 3, h2 = r >> 1;
        Unit t;
        t.pm = whole ? (pp >> 16) : TL / BM + (s >> 4); t.pn = whole ? (pp & 0xffff) : ((s >> 2) & 3);
        t.k0 = whole ? 0 : part * q + 2 * (part < h2 ? part : h2); t.nt = whole ? lat.ktiles : q + (part < h2 ? 2 : 0); t.part = whole ? 0 : part;
        u = t; return true;
    }
};

template <class Epi, class Sched = StaticOrder, bool ALIGN_EPI = true>
__device__ __forceinline__ void gemm_phase(LAS unsigned char* lds, const Gemm g, const Sched& S, const Epi& E) {
    const int tid = opaque_tid(), wid = __builtin_amdgcn_readfirstlane(tid >> 6), lane = tid & 63, wr = wid >> 2, wc = wid & 3, fr = lane & 15, fq = lane >> 4;
    const int K = g.K;
    unsigned voffA[2], voffB[2];
#pragma unroll
    for (int i = 0; i < 2; ++i) { int R, C; stage_rc(tid * 16 + i * 8192, R, C); const int Rb = (R & ~31) + perm32(R & 31); voffA[i] = (unsigned)(R * K + C) * 2u; voffB[i] = (unsigned)(Rb * K + C) * 2u; }
    const size_t kstep = (size_t)(BK * 2);
    const size_t hstep = (size_t)HALF * K * 2;
    const size_t tstep = 2 * hstep;
    const unsigned ldsw = (unsigned)wid * 1024u;
    const int aoff = lds_byte(wr * 64 + fr, fq * 8), boff = lds_byte(wc * 32 + fr, fq * 8);
#define PG8_SA(b, h) (((b) * 2 + (h)) * HTB)
#define PG8_SB(b, h) ((4 + (b) * 2 + (h)) * HTB)
#define PG8_STAGE(bufoff, gbase, voff) do { _Pragma("unroll") for (int _i = 0; _i < 2; ++_i) \
        __builtin_amdgcn_global_load_lds((const unsigned*)((const char*)(gbase) + (voff)[_i]), (LAS unsigned*)(lds + (bufoff) + ldsw + _i * 8192), 16, 0, 0); } while (0)
#define PG8_LDA(dst, b, h) do { _Pragma("unroll") for (int m = 0; m < 4; ++m) _Pragma("unroll") for (int k = 0; k < 2; ++k) dst[m][k] = *(const LAS bf16x8*)(lds + PG8_SA(b, h) + aoff + m * 2048 + k * 1024); } while (0)
#define PG8_LDB(dst, b, h) do { _Pragma("unroll") for (int n = 0; n < 2; ++n) _Pragma("unroll") for (int k = 0; k < 2; ++k) dst[n][k] = *(const LAS bf16x8*)(lds + PG8_SB(b, h) + boff + n * 2048 + k * 1024); } while (0)
#define PG8_MMA(ai, bj, At, Bt) do { __builtin_amdgcn_s_setprio(1); _Pragma("unroll") for (int m = 0; m < 4; ++m) _Pragma("unroll") for (int n = 0; n < 2; ++n) _Pragma("unroll") for (int k = 0; k < 2; ++k) \
        acc[ai][bj][m][n] = __builtin_amdgcn_mfma_f32_16x16x32_bf16(Bt[n][k], At[m][k], acc[ai][bj][m][n], 0, 0, 0); __builtin_amdgcn_s_setprio(0); } while (0)
#define PG8_WAIT_V(n) asm volatile("s_waitcnt vmcnt(" #n ")" ::: "memory")
#define PG8_WAIT_L(n) asm volatile("s_waitcnt lgkmcnt(" #n ")" ::: "memory")
#define PG8_BAR __builtin_amdgcn_s_barrier()
#define PG8_SCHED __builtin_amdgcn_sched_barrier(0)
    Unit cur, nxt; int ui = 0;
    if (!S.next(0, cur)) return;
    f32x4 acc[2][2][4][2];
#pragma unroll
    for (int a = 0; a < 2; ++a)
#pragma unroll
        for (int b = 0; b < 2; ++b)
#pragma unroll
            for (int m = 0; m < 4; ++m)
#pragma unroll
                for (int n = 0; n < 2; ++n) acc[a][b][m][n] = (f32x4){0.f, 0.f, 0.f, 0.f};
    bf16x8 At[4][2], B0[2][2], B1[2][2];
    const char* cA = (const char*)g.A + (size_t)cur.pm * tstep + (size_t)cur.k0 * kstep; const char* cB = (const char*)g.Bt + (size_t)cur.pn * tstep + (size_t)cur.k0 * kstep;
    PG8_STAGE(PG8_SB(0, 0), cB, voffB); PG8_STAGE(PG8_SB(0, 1), cB + hstep, voffB); PG8_STAGE(PG8_SA(0, 0), cA, voffA); PG8_STAGE(PG8_SA(0, 1), cA + hstep, voffA);
    if (wr == 1) PG8_BAR;
    PG8_WAIT_V(2); PG8_BAR;
    PG8_STAGE(PG8_SB(1, 0), cB + kstep, voffB); PG8_STAGE(PG8_SA(1, 0), cA + kstep, voffA); PG8_STAGE(PG8_SB(1, 1), cB + hstep + kstep, voffB);
    PG8_WAIT_V(6); PG8_BAR;
    for (;;) {
        const bool has_next = S.next(ui + 1, nxt);
        const char* nA = has_next ? (const char*)g.A + (size_t)nxt.pm * tstep + (size_t)nxt.k0 * kstep : cA; const char* nB = has_next ? (const char*)g.Bt + (size_t)nxt.pn * tstep + (size_t)nxt.k0 * kstep : cB;
        const int nt = cur.nt;
        for (int t = 0; t < nt; t += 2) {
            const bool last = (t == nt - 2);
            const char* a1 = cA + (size_t)(t + 1) * kstep;
            const char* a2 = last ? nA : cA + (size_t)(t + 2) * kstep; const char* b2 = last ? nB : cB + (size_t)(t + 2) * kstep;
            const char* a3 = a2 + kstep; const char* b3 = b2 + kstep;
            PG8_LDB(B0, 0, 0); PG8_LDB(B1, 0, 1); PG8_SCHED; PG8_LDA(At, 0, 0); PG8_STAGE(PG8_SA(1, 1), a1 + hstep, voffA);
            PG8_WAIT_V(8); PG8_WAIT_L(0); PG8_BAR; PG8_MMA(0, 0, At, B0); PG8_MMA(0, 1, At, B1); PG8_BAR; PG8_SCHED;
            PG8_LDA(At, 0, 1); PG8_STAGE(PG8_SB(0, 0), b2, voffB); PG8_STAGE(PG8_SB(0, 1), b2 + hstep, voffB); PG8_STAGE(PG8_SA(0, 0), a2, voffA);
            PG8_WAIT_V(8); PG8_WAIT_L(0); PG8_BAR; PG8_MMA(1, 0, At, B0); PG8_MMA(1, 1, At, B1); PG8_BAR; PG8_SCHED;
            PG8_LDB(B0, 1, 0); PG8_LDB(B1, 1, 1); PG8_SCHED; PG8_LDA(At, 1, 0); PG8_STAGE(PG8_SA(0, 1), a2 + hstep, voffA);
            PG8_WAIT_V(8); PG8_WAIT_L(0); PG8_BAR; PG8_MMA(0, 0, At, B0); PG8_MMA(0, 1, At, B1); PG8_BAR; PG8_SCHED;
            PG8_LDA(At, 1, 1); PG8_STAGE(PG8_SB(1, 0), b3, voffB); PG8_STAGE(PG8_SB(1, 1), b3 + hstep, voffB); PG8_STAGE(PG8_SA(1, 0), a3, voffA);
            PG8_WAIT_V(8); PG8_WAIT_L(0); PG8_BAR; PG8_MMA(1, 0, At, B0); PG8_MMA(1, 1, At, B1); PG8_BAR; PG8_SCHED;
        }
        if constexpr (ALIGN_EPI) { if (wr == 0) PG8_BAR; }
        E(acc, cur, wr, wc, fr, fq);
        if (!has_next) break;
#pragma unroll
        for (int a = 0; a < 2; ++a)
#pragma unroll
            for (int b = 0; b < 2; ++b)
#pragma unroll
                for (int m = 0; m < 4; ++m)
#pragma unroll
                    for (int n = 0; n < 2; ++n) acc[a][b][m][n] = (f32x4){0.f, 0.f, 0.f, 0.f};
        cur = nxt; cA = nA; cB = nB; ++ui;
        if constexpr (ALIGN_EPI) { if (wr == 1) PG8_BAR; }
    }
    PG8_WAIT_V(0);
    if constexpr (!ALIGN_EPI) { if (wr == 0) PG8_BAR; }
    PG8_BAR;
#undef PG8_SA
#undef PG8_SB
#undef PG8_STAGE
#undef PG8_LDA
#undef PG8_LDB
#undef PG8_MMA
#undef PG8_WAIT_V
#undef PG8_WAIT_L
#undef PG8_BAR
#undef PG8_SCHED
}
}
using pg8::Unit;
typedef f32x4 AccT[2][2][4][2];

#define PACK8(v0, v1) (u32x4){cvt_pk_bf16((v0)[0], (v0)[1]), cvt_pk_bf16((v0)[2], (v0)[3]), cvt_pk_bf16((v1)[0], (v1)[1]), cvt_pk_bf16((v1)[2], (v1)[3])}
struct EpiPlain {
    bf16_t* O; size_t ldc;
    __device__ __forceinline__ void operator()(const AccT& acc, const Unit& u, int wr, int wc, int fr, int fq) const {
        const int row0 = u.pm * 256 + wr * 64 + fr, col0 = u.pn * 256 + wc * 32 + 8 * fq;
#pragma unroll
        for (int ai = 0; ai < 2; ++ai)
#pragma unroll
            for (int m = 0; m < 4; ++m) { bf16_t* rowp = O + (size_t)(row0 + ai * 128 + m * 16) * ldc + col0;
#pragma unroll
                for (int bj = 0; bj < 2; ++bj) *(u32x4*)(rowp + bj * 128) = PACK8(acc[ai][bj][m][0], acc[ai][bj][m][1]); }
    }
};
struct EpiGla {
    bf16_t *QDf, *KIf, *QDb, *KIb, *R; float* ET; const float *b_r, *b_a;
    __device__ __forceinline__ void operator()(const AccT& acc, const Unit& u, int wr, int wc, int fr, int fq) const {
        const int row0 = u.pm * 256 + wr * 64 + fr;
        const int pn = u.pn;
        if (pn < 8) {
            const int d0 = 64 * pn + 16 * wc + 4 * fq;
            const f32x4 baf = *(const f32x4*)(b_a + d0), bab = *(const f32x4*)(b_a + 512 + d0);
#pragma unroll
            for (int ai = 0; ai < 2; ++ai) {
                f32x4 pf[4], pb[4];
#pragma unroll
                for (int m = 0; m < 4; ++m) {
                    const f32x4 xf = acc[ai][1][m][0] + baf, xb = acc[ai][1][m][1] + bab;
#pragma unroll
                    for (int j = 0; j < 4; ++j) { pf[m][j] = (fminf(xf[j], 0.f) - __logf(1.0f + __expf(-fabsf(xf[j])))) * 0.0625f; pb[m][j] = (fminf(xb[j], 0.f) - __logf(1.0f + __expf(-fabsf(xb[j])))) * 0.0625f; }
                }
                f32x4 lb[4];
#pragma unroll
                for (int m = 0; m < 4; ++m) lb[m] = pb[m];
#pragma unroll
                for (int dl = 1; dl < 16; dl <<= 1) {
#pragma unroll
                    for (int m = 0; m < 4; ++m)
#pragma unroll
                        for (int j = 0; j < 4; ++j) { const float tf = __shfl_up(pf[m][j], dl, 16), tb = __shfl_up(pb[m][j], dl, 16); if (fr >= dl) { pf[m][j] += tf; pb[m][j] += tb; } }
                }
                f32x4 of = (f32x4){0.f, 0.f, 0.f, 0.f}, ob = of;
#pragma unroll
                for (int m = 0; m < 4; ++m)
#pragma unroll
                    for (int j = 0; j < 4; ++j) { const float tf = __shfl(pf[m][j], 15, 16), tb = __shfl(pb[m][j], 15, 16); pf[m][j] += of[j]; pb[m][j] += ob[j]; of[j] += tf; ob[j] += tb; }
                const int rbase = row0 + ai * 128;
                if (fr == 0) { const int chunk = (u.pm * 256 + ai * 128 + wr * 64) >> 6; f32x4 e0, e1;
#pragma unroll
                    for (int j = 0; j < 4; ++j) { e0[j] = __expf(of[j]); e1[j] = __expf(ob[j]); }
                    *(f32x4*)(ET + ((size_t)chunk * 2 + 0) * 512 + d0) = e0; *(f32x4*)(ET + ((size_t)chunk * 2 + 1) * 512 + d0) = e1; }
#pragma unroll
                for (int m = 0; m < 4; ++m) {
                    const f32x4 q = acc[ai][0][m][0] * 0.08838834764831845f, k = acc[ai][0][m][1];
                    f32x4 qf, kf, qb, kb;
#pragma unroll
                    for (int j = 0; j < 4; ++j) { const float bfw = pf[m][j], bbw = ob[j] - pb[m][j] + lb[m][j];
                        const float ef = __expf(bfw), eb = __expf(bbw);
                        qf[j] = q[j] * ef; kf[j] = k[j] * __builtin_amdgcn_rcpf(ef); qb[j] = q[j] * eb; kb[j] = k[j] * __builtin_amdgcn_rcpf(eb); }
                    const size_t off = (size_t)(rbase + m * 16) * 512 + d0;
                    u32x2 w;
                    w.x = cvt_pk_bf16(qf[0], qf[1]); w.y = cvt_pk_bf16(qf[2], qf[3]); *(u32x2*)(QDf + off) = w;
                    w.x = cvt_pk_bf16(kf[0], kf[1]); w.y = cvt_pk_bf16(kf[2], kf[3]); *(u32x2*)(KIf + off) = w;
                    w.x = cvt_pk_bf16(qb[0], qb[1]); w.y = cvt_pk_bf16(qb[2], qb[3]); *(u32x2*)(QDb + off) = w;
                    w.x = cvt_pk_bf16(kb[0], kb[1]); w.y = cvt_pk_bf16(kb[2], kb[3]); *(u32x2*)(KIb + off) = w;
                }
            }
        } else {
            const int col0 = (pn - 8) * 256 + wc * 32 + 8 * fq;
            f32x4 bv[2][2];
#pragma unroll
            for (int bj = 0; bj < 2; ++bj)
#pragma unroll
                for (int n = 0; n < 2; ++n) bv[bj][n] = *(const f32x4*)(b_r + col0 + bj * 128 + n * 4);
#pragma unroll
            for (int ai = 0; ai < 2; ++ai)
#pragma unroll
                for (int m = 0; m < 4; ++m) { bf16_t* rowp = R + (size_t)(row0 + ai * 128 + m * 16) * 1024 + col0;
#pragma unroll
                    for (int bj = 0; bj < 2; ++bj) { f32x4 v0 = acc[ai][bj][m][0] + bv[bj][0], v1 = acc[ai][bj][m][1] + bv[bj][1];
#pragma unroll
                        for (int j = 0; j < 4; ++j) { v0[j] = silu_f(v0[j]); v1[j] = silu_f(v1[j]); }
                        *(u32x4*)(rowp + bj * 128) = PACK8(v0, v1); } }
        }
    }
};
struct EpiDelta {
    bf16_t* D; const float* gate; bf16_t* Dp; int split;
    __device__ __forceinline__ void operator()(const AccT& acc, const Unit& u, int wr, int wc, int fr, int fq) const {
        const int rt = u.pm * 256; const int b = rt >= TL ? 16 : (rt >> 11);
        const int colt = u.pn * 256 + wc * 32 + 8 * fq;
        const float* gp = gate + (size_t)b * NADA + colt;
        f32x4 gv[2][2];
#pragma unroll
        for (int bj = 0; bj < 2; ++bj)
#pragma unroll
            for (int n = 0; n < 2; ++n) gv[bj][n] = *(const f32x4*)(gp + bj * 128 + n * 4);
#pragma unroll
        for (int ai = 0; ai < 2; ++ai)
#pragma unroll
            for (int m = 0; m < 4; ++m) { bf16_t* rowp = (split && rt >= TL ? Dp + (size_t)u.part * TC * DM + (size_t)(rt - TL + wr * 64 + fr + ai * 128 + m * 16) * DM : D + (size_t)(rt + wr * 64 + fr + ai * 128 + m * 16) * DM) + colt;
#pragma unroll
                for (int bj = 0; bj < 2; ++bj) { const f32x4 v0 = gv[bj][0] * acc[ai][bj][m][0], v1 = gv[bj][1] * acc[ai][bj][m][1]; *(u32x4*)(rowp + bj * 128) = PACK8(v0, v1); } }
    }
};
struct EpiConvIn {
    bf16_t* PU;
    __device__ __forceinline__ void operator()(const AccT& acc, const Unit& u, int wr, int wc, int fr, int fq) const {
        const int row0 = u.pm * 256 + wr * 64 + fr;
        if (u.pn < 4) {
            const int col0 = u.pn * 256 + wc * 32 + 8 * fq;
#pragma unroll
            for (int ai = 0; ai < 2; ++ai)
#pragma unroll
                for (int m = 0; m < 4; ++m) { bf16_t* rowp = PU + (size_t)(row0 + ai * 128 + m * 16) * 2048 + col0;
#pragma unroll
                    for (int bj = 0; bj < 2; ++bj) *(u32x4*)(rowp + bj * 128) = PACK8(acc[ai][bj][m][0], acc[ai][bj][m][1]); }
        } else {
            const int col0 = 1024 + (u.pn - 4) * 128 + wc * 32 + 8 * fq;
#pragma unroll
            for (int ai = 0; ai < 2; ++ai)
#pragma unroll
                for (int m = 0; m < 4; ++m) { bf16_t* rowp = PU + (size_t)(row0 + ai * 128 + m * 16) * 2048 + col0;
                    const f32x4 v0 = acc[ai][0][m][0] * acc[ai][1][m][0], v1 = acc[ai][0][m][1] * acc[ai][1][m][1];
                    *(u32x4*)(rowp) = PACK8(v0, v1); }
        }
    }
};
struct EpiSwiglu {
    bf16_t* F;
    __device__ __forceinline__ void operator()(const AccT& acc, const Unit& u, int wr, int wc, int fr, int fq) const {
        const int row0 = u.pm * 256 + wr * 64 + fr, col0 = u.pn * 128 + wc * 32 + 8 * fq;
#pragma unroll
        for (int ai = 0; ai < 2; ++ai)
#pragma unroll
            for (int m = 0; m < 4; ++m) { bf16_t* rowp = F + (size_t)(row0 + ai * 128 + m * 16) * DFF + col0;
                f32x4 v0, v1;
#pragma unroll
                for (int j = 0; j < 4; ++j) { v0[j] = silu_f(acc[ai][0][m][0][j]) * acc[ai][1][m][0][j]; v1[j] = silu_f(acc[ai][0][m][1][j]) * acc[ai][1][m][1][j]; }
                *(u32x4*)(rowp) = PACK8(v0, v1); }
    }
};

__device__ __forceinline__ void ada_phase(LAS unsigned char* lds, const Params& P) {
    LAS float* sc = (LAS float*)lds;
    LAS float* red = sc + NCOND * 1024;
    const int tid = opaque_tid(), wave = tid >> 6, lane = tid & 63;
    const float* c = P.in[I_C]; const float* cctx = P.in[I_CCTX]; const float* adaw = P.in[I_ADAW]; const float* adab = P.in[I_ADAB];
    float* mod = (float*)(P.ws + WS_MOD);
    if ((int)blockIdx.x >= 192) return;
    for (int idx = tid; idx < NCOND * 1024; idx += 512) { const int b = idx >> 10, k = idx & 1023; const float v = b < 16 ? c[b * 1024 + k] : cctx[k]; sc[idx] = silu_f(v); }
    __syncthreads();
    for (int item = blockIdx.x; item < 192; item += gridDim.x) {
        const int l = item / 48, n0 = (item % 48) * 128;
        float acc[NCOND][2];
#pragma unroll
        for (int b = 0; b < NCOND; ++b) { acc[b][0] = 0.f; acc[b][1] = 0.f; }
        const float* wbase = adaw + ((size_t)l * 1024) * NADA + n0 + 2 * lane;
        for (int k = 128 * wave; k < 128 * wave + 128; k += 16) {
            f32x2 wv[16];
#pragma unroll
            for (int i = 0; i < 16; ++i) wv[i] = __builtin_nontemporal_load((const f32x2*)(wbase + (size_t)(k + i) * NADA));
#pragma unroll
            for (int b = 0; b < NCOND; ++b) {
#pragma unroll
                for (int kk = 0; kk < 16; kk += 4) { const f32x4 s4 = *(const LAS f32x4*)(sc + b * 1024 + k + kk);
                    acc[b][0] += s4[0] * wv[kk][0] + s4[1] * wv[kk + 1][0] + s4[2] * wv[kk + 2][0] + s4[3] * wv[kk + 3][0];
                    acc[b][1] += s4[0] * wv[kk][1] + s4[1] * wv[kk + 1][1] + s4[2] * wv[kk + 2][1] + s4[3] * wv[kk + 3][1]; } }
        }
#pragma unroll
        for (int b = 0; b < NCOND; ++b) { red[(wave * NCOND + b) * 128 + 2 * lane] = acc[b][0]; red[(wave * NCOND + b) * 128 + 2 * lane + 1] = acc[b][1]; }
        __syncthreads();
        for (int idx = tid; idx < NCOND * 128; idx += 512) { const int b = idx >> 7, cc = idx & 127; float s = 0.f;
#pragma unroll
            for (int w = 0; w < 8; ++w) s += red[(w * NCOND + b) * 128 + cc];
            mod[((size_t)l * NCOND + b) * NADA + n0 + cc] = s + adab[l * NADA + n0 + cc]; }
        __syncthreads();
    }
}

__host__ __device__ __forceinline__ int qkl_row(int type, int d) { return 256 * (d >> 6) + 128 * (type >> 1) + 32 * ((d >> 4) & 3) + 8 * ((d >> 2) & 3) + 4 * (type & 1) + (d & 3); }
__device__ __forceinline__ void transpose_item(const float* W, int K, int N, bf16_t* WT, int wt_row0, int k0, int n0, LAS float* scr, int lane, int qkl_type = -1) {
#pragma unroll 8
    for (int i = 0; i < 32; ++i) { const int kk = 2 * i + (lane >> 5); scr[kk * 33 + (lane & 31)] = __builtin_nontemporal_load(W + (size_t)(k0 + kk) * N + n0 + (lane & 31)); }
    LDS_WAIT(); asm volatile("" ::: "memory");
    const int c = lane & 7;
#pragma unroll
    for (int j = 0; j < 4; ++j) { const int n = (lane >> 3) + 8 * j; const LAS float* s = scr + (8 * c) * 33 + n;
        u32x4 o; o.x = cvt_pk_bf16(s[0 * 33], s[1 * 33]); o.y = cvt_pk_bf16(s[2 * 33], s[3 * 33]); o.z = cvt_pk_bf16(s[4 * 33], s[5 * 33]); o.w = cvt_pk_bf16(s[6 * 33], s[7 * 33]);
        const int drow = qkl_type >= 0 ? qkl_row(qkl_type, wt_row0 + n) : wt_row0 + n;
        *(u32x4*)(WT + (size_t)drow * K + k0 + 8 * c) = o; }
    LDS_WAIT(); asm volatile("" ::: "memory");
}
__device__ __forceinline__ void prep_layer(LAS unsigned char* lds, const Params& P, int layer, int c0, int nblk) {
    const int tid = opaque_tid(), wave = tid >> 6, lane = tid & 63;
    const int kind = layer & 1, j = layer >> 1;
    LAS float* scr = (LAS float*)(lds + wave * 8704);
    unsigned char* wb = P.ws + ((layer & 1) ? WS_W2 : 0);
    bf16_t* Win_t = (bf16_t*)(wb + WS_WIN); bf16_t* Wout_t = (bf16_t*)(wb + WS_WOUT); bf16_t* Wf1_t = (bf16_t*)(wb + WS_WF1); bf16_t* Wf2_t = (bf16_t*)(wb + WS_WF2);
    const float* Win = (kind == 0 ? P.in[I_CWIN] : P.in[I_GWIN]) + (size_t)j * 1024 * 3072;
    const float* Wout = (kind == 0 ? P.in[I_CWOUT] : P.in[I_GWOUT]) + (size_t)j * 1024 * 1024;
    const float* Wf1 = P.in[I_FWIN] + (size_t)layer * 1024 * 5632;
    const float* Wf2 = P.in[I_FWOUT] + (size_t)layer * 2816 * 1024;
    const int gw = ((int)blockIdx.x - c0) * 8 + wave, NGW = nblk * 8;
    for (int it = gw; it < 6272; it += NGW) {
        if (it < 1536) { const int kb = it / 96, n0 = (it % 96) * 32;
            if (kind == 0) { const int row0 = n0 < 1024 ? n0 : (n0 < 2048 ? 1024 + 256 * ((n0 - 1024) / 128) + ((n0 - 1024) % 128) : 1024 + 256 * ((n0 - 2048) / 128) + 128 + ((n0 - 2048) % 128));
                transpose_item(Win, 1024, 3072, Win_t, row0, kb * 64, n0, scr, lane); }
            else if (n0 < 1024) transpose_item(Win, 1024, 3072, Win_t, n0 & 511, kb * 64, n0, scr, lane, n0 >> 9);
            else transpose_item(Win, 1024, 3072, Win_t, n0 < 2048 ? n0 + 2048 : n0, kb * 64, n0, scr, lane); }
        else if (it < 2048) { const int r = it - 1536; const int kb = r / 32, n0 = (r % 32) * 32; transpose_item(Wout, 1024, 1024, Wout_t, n0, kb * 64, n0, scr, lane); }
        else if (it < 4864) { const int r = it - 2048; const int kb = r / 176, n0 = (r % 176) * 32;
            const int row0 = n0 < 2816 ? 256 * (n0 / 128) + (n0 % 128) : 256 * ((n0 - 2816) / 128) + 128 + ((n0 - 2816) % 128);
            transpose_item(Wf1, 1024, 5632, Wf1_t, row0, kb * 64, n0, scr, lane); }
        else { const int r = it - 4864; const int kb = r / 32, n0 = (r % 32) * 32; transpose_item(Wf2, 2816, 1024, Wf2_t, n0, kb * 64, n0, scr, lane); }
    }
    if (kind == 1) {
        const float* a1 = P.in[I_GA1] + (size_t)j * 2 * 1024 * 16; const float* a2 = P.in[I_GA2] + (size_t)j * 2 * 16 * 512;
        const int gt = ((int)blockIdx.x - c0) * 512 + tid, NT = nblk * 512;
        for (int idx = gt; idx < 1024 * 128; idx += NT) {
            const int row = idx >> 7, kg = idx & 127, dir = row >> 9, d = row & 511;
            float a2v[16];
#pragma unroll
            for (int r = 0; r < 16; ++r) a2v[r] = a2[((size_t)dir * 16 + r) * 512 + d];
            float o[8];
#pragma unroll
            for (int kk = 0; kk < 8; ++kk) { const f32x4* ar = (const f32x4*)(a1 + ((size_t)dir * 1024 + 8 * kg + kk) * 16); float s = 0.f;
#pragma unroll
                for (int q = 0; q < 4; ++q) { const f32x4 av = ar[q]; s += av[0] * a2v[4 * q] + av[1] * a2v[4 * q + 1] + av[2] * a2v[4 * q + 2] + av[3] * a2v[4 * q + 3]; }
                o[kk] = s; }
            u32x4 w; w.x = cvt_pk_bf16(o[0], o[1]); w.y = cvt_pk_bf16(o[2], o[3]); w.z = cvt_pk_bf16(o[4], o[5]); w.w = cvt_pk_bf16(o[6], o[7]);
            *(u32x4*)(Win_t + (size_t)qkl_row(2 + dir, d) * 1024 + 8 * kg) = w;
        }
    }
}

__device__ __forceinline__ void norm_mod_phase(const float* src_lat, const float* src_ctx, const bf16_t* delta, const bf16_t* dparts, float* xo_lat, float* xo_ctx,
                                               const float* gain, const float* modl, int shoff, int scoff, bf16_t* H, int nrows) {
    const int tid = opaque_tid(), wave = tid >> 6, lane = tid & 63;
    const int gw = blockIdx.x * 8 + wave, NGW = gridDim.x * 8;
    for (int r0 = gw * 4; r0 < nrows; r0 += NGW * 4) {
        const float* xrow = r0 < TL ? src_lat + (size_t)r0 * DM : src_ctx + (size_t)(r0 - TL) * DM; const int b = r0 < TL ? (r0 >> 11) : 16;
        float* xout = r0 < TL ? xo_lat + (size_t)r0 * DM : xo_ctx + (size_t)(r0 - TL) * DM;
        f32x4 v[4][4]; float ss[4];
#pragma unroll
        for (int i = 0; i < 4; ++i)
#pragma unroll
            for (int q = 0; q < 4; ++q) v[i][q] = __builtin_nontemporal_load((const f32x4*)(xrow + (size_t)i * DM) + lane + 64 * q);
        if (delta) {
            const int np = (dparts && r0 >= TL) ? 4 : 1;
            for (int p = 0; p < np; ++p) {
                const bf16_t* dsrc = np == 4 ? dparts + (size_t)p * TC * DM + (size_t)(r0 - TL) * DM : delta + (size_t)r0 * DM;
                u32x2 dv[4][4];
#pragma unroll
                for (int i = 0; i < 4; ++i)
#pragma unroll
                    for (int q = 0; q < 4; ++q) dv[i][q] = __builtin_nontemporal_load((const u32x2*)(dsrc + (size_t)i * DM + 4 * lane + 256 * q));
#pragma unroll
                for (int i = 0; i < 4; ++i)
#pragma unroll
                    for (int q = 0; q < 4; ++q) { v[i][q][0] += bf2f((unsigned short)(dv[i][q].x & 0xffff)); v[i][q][1] += bf2f((unsigned short)(dv[i][q].x >> 16));
                        v[i][q][2] += bf2f((unsigned short)(dv[i][q].y & 0xffff)); v[i][q][3] += bf2f((unsigned short)(dv[i][q].y >> 16)); }
            }
        }
#pragma unroll
        for (int i = 0; i < 4; ++i)
#pragma unroll
            for (int q = 0; q < 4; ++q) { if (xo_lat) __builtin_nontemporal_store(v[i][q], (f32x4*)(xout + (size_t)i * DM) + lane + 64 * q); }
        const float* mb = modl + (size_t)b * NADA;
        f32x4 g4[4], sc4[4], sh4[4];
#pragma unroll
        for (int q = 0; q < 4; ++q) { const int col = 4 * lane + 256 * q; g4[q] = *(const f32x4*)(gain + col); sc4[q] = *(const f32x4*)(mb + scoff + col) + 1.0f; sh4[q] = *(const f32x4*)(mb + shoff + col); }
#pragma unroll
        for (int i = 0; i < 4; ++i) { float s = 0.f;
#pragma unroll
            for (int q = 0; q < 4; ++q) s += (v[i][q][0] * v[i][q][0] + v[i][q][1] * v[i][q][1]) + (v[i][q][2] * v[i][q][2] + v[i][q][3] * v[i][q][3]);
            ss[i] = s; }
#pragma unroll
        for (int o = 1; o < 64; o <<= 1) {
#pragma unroll
            for (int i = 0; i < 4; ++i) ss[i] += __shfl_xor(ss[i], o); }
#pragma unroll
        for (int i = 0; i < 4; ++i) { const float rstd = rsqrtf(ss[i] * (1.0f / DM) + 1e-6f);
#pragma unroll
            for (int q = 0; q < 4; ++q) { const int col = 4 * lane + 256 * q; const f32x4 h = (v[i][q] * rstd * g4[q]) * sc4[q] + sh4[q];
                u32x2 w; w.x = cvt_pk_bf16(h[0], h[1]); w.y = cvt_pk_bf16(h[2], h[3]); *(u32x2*)(H + (size_t)(r0 + i) * DM + col) = w; } }
    }
}
__device__ __forceinline__ void final_norm_phase(const float* X, const bf16_t* delta, const float* gain, float* out) {
    const int tid = opaque_tid(), wave = tid >> 6, lane = tid & 63;
    const int gw = blockIdx.x * 8 + wave, NGW = gridDim.x * 8;
    for (int r0 = gw * 4; r0 < TL; r0 += NGW * 4) {
        f32x4 v[4][4]; float ss[4]; u32x2 dv[4][4];
#pragma unroll
        for (int i = 0; i < 4; ++i)
#pragma unroll
            for (int q = 0; q < 4; ++q) { v[i][q] = __builtin_nontemporal_load((const f32x4*)(X + (size_t)(r0 + i) * DM) + lane + 64 * q); dv[i][q] = __builtin_nontemporal_load((const u32x2*)(delta + (size_t)(r0 + i) * DM + 4 * lane + 256 * q)); }
        f32x4 g4[4];
#pragma unroll
        for (int q = 0; q < 4; ++q) g4[q] = *(const f32x4*)(gain + 4 * lane + 256 * q);
#pragma unroll
        for (int i = 0; i < 4; ++i) { float s = 0.f;
#pragma unroll
            for (int q = 0; q < 4; ++q) { v[i][q][0] += bf2f((unsigned short)(dv[i][q].x & 0xffff)); v[i][q][1] += bf2f((unsigned short)(dv[i][q].x >> 16));
                v[i][q][2] += bf2f((unsigned short)(dv[i][q].y & 0xffff)); v[i][q][3] += bf2f((unsigned short)(dv[i][q].y >> 16));
                s += (v[i][q][0] * v[i][q][0] + v[i][q][1] * v[i][q][1]) + (v[i][q][2] * v[i][q][2] + v[i][q][3] * v[i][q][3]); }
            ss[i] = s; }
#pragma unroll
        for (int o = 1; o < 64; o <<= 1) {
#pragma unroll
            for (int i = 0; i < 4; ++i) ss[i] += __shfl_xor(ss[i], o); }
#pragma unroll
        for (int i = 0; i < 4; ++i) { const float rstd = rsqrtf(ss[i] * (1.0f / DM) + 1e-6f);
#pragma unroll
            for (int q = 0; q < 4; ++q) __builtin_nontemporal_store(v[i][q] * rstd * g4[q], (f32x4*)(out + (size_t)(r0 + i) * DM + 4 * lane + 256 * q)); }
    }
}
__device__ __forceinline__ void conv_phase(const bf16_t* PU, const float* cw, bf16_t* Z, int ntok) {
    const int gt = blockIdx.x * 512 + opaque_tid(), NT = gridDim.x * 512;
    const int total = (ntok >> 3) * 128;
    for (int idx = gt; idx < total; idx += NT) {
        const int t0 = (idx >> 7) * 8, cg8 = (idx & 127) * 8;
        int pos0, len; if (t0 < TL) { pos0 = t0 & 63; len = 64; } else { pos0 = (t0 - TL) & 255; len = 256; }
        const bf16_t* row = PU + (size_t)t0 * 2048 + cg8;
        const bool hasp = pos0 > 0, hasn = pos0 + 8 < len;
        u32x4 gbv[8], uv[10];
        const u32x4 z4 = (u32x4){0, 0, 0, 0};
        uv[0] = z4; uv[9] = z4;
        if (hasp) uv[0] = __builtin_nontemporal_load((const u32x4*)(row - 2048 + 1024));
#pragma unroll
        for (int i = 0; i < 8; ++i) { gbv[i] = __builtin_nontemporal_load((const u32x4*)(row + (size_t)i * 2048)); uv[i + 1] = __builtin_nontemporal_load((const u32x4*)(row + (size_t)i * 2048 + 1024)); }
        if (hasn) uv[9] = __builtin_nontemporal_load((const u32x4*)(row + (size_t)8 * 2048 + 1024));
        float w0[8], w1[8], w2[8];
#pragma unroll
        for (int e = 0; e < 8; ++e) { w0[e] = cw[cg8 + e]; w1[e] = cw[1024 + cg8 + e]; w2[e] = cw[2048 + cg8 + e]; }
#pragma unroll
        for (int i = 0; i < 8; ++i) {
            float o[8];
#pragma unroll
            for (int q = 0; q < 4; ++q) {
                const float gb0 = bf2f((unsigned short)(gbv[i][q] & 0xffff)), gb1 = bf2f((unsigned short)(gbv[i][q] >> 16));
                const float p0 = bf2f((unsigned short)(uv[i][q] & 0xffff)), p1 = bf2f((unsigned short)(uv[i][q] >> 16));
                const float c0 = bf2f((unsigned short)(uv[i + 1][q] & 0xffff)), c1 = bf2f((unsigned short)(uv[i + 1][q] >> 16));
                const float n0 = bf2f((unsigned short)(uv[i + 2][q] & 0xffff)), n1 = bf2f((unsigned short)(uv[i + 2][q] >> 16));
                o[2 * q] = gb0 * (w0[2 * q] * p0 + w1[2 * q] * c0 + w2[2 * q] * n0);
                o[2 * q + 1] = gb1 * (w0[2 * q + 1] * p1 + w1[2 * q + 1] * c1 + w2[2 * q + 1] * n1); }
            u32x4 w; w.x = cvt_pk_bf16(o[0], o[1]); w.y = cvt_pk_bf16(o[2], o[3]); w.z = cvt_pk_bf16(o[4], o[5]); w.w = cvt_pk_bf16(o[6], o[7]);
            *(u32x4*)(Z + (size_t)(t0 + i) * DM + cg8) = w;
        }
    }
}
__device__ __forceinline__ void gla_out_phase(const bf16_t* Of, const bf16_t* Ob, const bf16_t* R, const float* ng, bf16_t* G, int ntok) {
    const int tid = opaque_tid(), wave = tid >> 6, lane = tid & 63;
    const int gw = blockIdx.x * 8 + wave, NGW = gridDim.x * 8;
    const float* ngp = ng + ((16 * lane) & 255);
    float ngv[16];
#pragma unroll
    for (int e = 0; e < 16; ++e) ngv[e] = ngp[e];
    for (int t0 = gw * 2; t0 < ntok; t0 += NGW * 2) {
        u32x4 av[2][2], bv[2][2], rv[2][2];
#pragma unroll
        for (int i = 0; i < 2; ++i) { const size_t off = (size_t)(t0 + i) * DM + 16 * lane;
            av[i][0] = __builtin_nontemporal_load((const u32x4*)(Of + off)); av[i][1] = __builtin_nontemporal_load((const u32x4*)(Of + off + 8)); bv[i][0] = __builtin_nontemporal_load((const u32x4*)(Ob + off)); bv[i][1] = __builtin_nontemporal_load((const u32x4*)(Ob + off + 8));
            rv[i][0] = __builtin_nontemporal_load((const u32x4*)(R + off)); rv[i][1] = __builtin_nontemporal_load((const u32x4*)(R + off + 8)); }
#pragma unroll
        for (int i = 0; i < 2; ++i) {
            float o[16]; float s = 0.f;
#pragma unroll
            for (int hh = 0; hh < 2; ++hh)
#pragma unroll
                for (int q = 0; q < 4; ++q) {
                    o[8 * hh + 2 * q] = bf2f((unsigned short)(av[i][hh][q] & 0xffff)) + bf2f((unsigned short)(bv[i][hh][q] & 0xffff));
                    o[8 * hh + 2 * q + 1] = bf2f((unsigned short)(av[i][hh][q] >> 16)) + bf2f((unsigned short)(bv[i][hh][q] >> 16)); }
#pragma unroll
            for (int e = 0; e < 16; ++e) s += o[e] * o[e];
            s += __shfl_xor(s, 1); s += __shfl_xor(s, 2); s += __shfl_xor(s, 4); s += __shfl_xor(s, 8);
            const float rstd = rsqrtf(s * (1.0f / 256.0f) + 1e-6f);
            float y[16];
#pragma unroll
            for (int hh = 0; hh < 2; ++hh)
#pragma unroll
                for (int q = 0; q < 4; ++q) {
                    y[8 * hh + 2 * q] = o[8 * hh + 2 * q] * rstd * ngv[8 * hh + 2 * q] * bf2f((unsigned short)(rv[i][hh][q] & 0xffff));
                    y[8 * hh + 2 * q + 1] = o[8 * hh + 2 * q + 1] * rstd * ngv[8 * hh + 2 * q + 1] * bf2f((unsigned short)(rv[i][hh][q] >> 16)); }
            u32x4 w0, w1;
            w0.x = cvt_pk_bf16(y[0], y[1]); w0.y = cvt_pk_bf16(y[2], y[3]); w0.z = cvt_pk_bf16(y[4], y[5]); w0.w = cvt_pk_bf16(y[6], y[7]);
            w1.x = cvt_pk_bf16(y[8], y[9]); w1.y = cvt_pk_bf16(y[10], y[11]); w1.z = cvt_pk_bf16(y[12], y[13]); w1.w = cvt_pk_bf16(y[14], y[15]);
            const size_t off = (size_t)(t0 + i) * DM + 16 * lane;
            *(u32x4*)(G + off) = w0; *(u32x4*)(G + off + 8) = w1;
        }
    }
}

constexpr int SC_QD = 0, SC_KI = 18432, SC_KDT = 36864, SC_VT = 57344, SC_ST = 77824, SC_P = 114688, SC_TOT = 124928, SC_DEC = 124928, SC_LA = 125440, SC_ET = 125440  ;
constexpr int PQ = 144, PS = 80;
__device__ __forceinline__ void gla_scan_phase(LAS unsigned char* lds, const bf16_t* QDf, const bf16_t* KIf, const bf16_t* QDb, const bf16_t* KIb, const float* ET, const bf16_t* VT, bf16_t* Of, bf16_t* Ob) {
    const int tid = opaque_tid(), w = __builtin_amdgcn_readfirstlane(tid >> 6), lane = tid & 63, fr = lane & 15, fq = lane >> 4;
    LAS bf16_t* QD = (LAS bf16_t*)(lds + SC_QD); LAS bf16_t* KI = (LAS bf16_t*)(lds + SC_KI); LAS bf16_t* KDT = (LAS bf16_t*)(lds + SC_KDT);
    LAS bf16_t* VTs = (LAS bf16_t*)(lds + SC_VT); LAS bf16_t* ST = (LAS bf16_t*)(lds + SC_ST); LAS bf16_t* Pm = (LAS bf16_t*)(lds + SC_P);
    LAS float* TOT = (LAS float*)(lds + SC_TOT); LAS float* DEC = (LAS float*)(lds + SC_DEC);
    const int d = tid & 127, seg = tid >> 7;
    for (int item = blockIdx.x; item < 256; item += gridDim.x) {
        const int es = item & 1, dir = (item >> 1) & 1, h = (item >> 2) & 3, b = item >> 4;
        bf16_t* Od = dir ? Ob : Of;
        for (int i = tid; i < 128 * PQ / 2; i += 512) ((LAS unsigned*)ST)[i] = 0u;
#define SCAN_TOK0(st) ((st) < 4 ? (TL + b * 256 + (dir ? 3 - (st) : (st)) * 64) : (b * 2048 + (dir ? 31 - ((st) - 4) : ((st) - 4)) * 64))
        LAS float* ETL = (LAS float*)(lds + SC_ET);
        for (int i = tid; i < 36 * 128; i += 512) { const int st = i >> 7, dd = i & 127; const int t0_ = SCAN_TOK0(st); ETL[i] = ET[((size_t)(t0_ >> 6) * 2 + dir) * 512 + h * 128 + dd]; }
        f32x4 S[8];
#pragma unroll
        for (int dt = 0; dt < 8; ++dt) S[dt] = (f32x4){0.f, 0.f, 0.f, 0.f};
        __syncthreads();
        const bf16_t* QDg = dir ? QDb : QDf; const bf16_t* KIg = dir ? KIb : KIf;
        u32x4 qv[2][2], kv[2][2], vtv[2][2];
        const int krow = tid & 63, kc8 = (tid >> 6) * 8;
#define SCAN_LOAD(st, S) do { const int _t0 = SCAN_TOK0(st); \
            _Pragma("unroll") for (int i = 0; i < 2; ++i) { const int piece = tid + 512 * i; const int row = piece >> 4, c8 = (piece & 15) * 8; \
                qv[S][i] = *(const u32x4*)(QDg + (size_t)(_t0 + row) * 512 + h * 128 + c8); \
                kv[S][i] = *(const u32x4*)(KIg + (size_t)(_t0 + krow) * 512 + h * 128 + kc8 + 64 * i); \
                const int er = piece >> 3, pc = piece & 7; vtv[S][i] = *(const u32x4*)(VT + (size_t)(h * 256 + es * 128 + er) * TT + _t0 + 8 * pc); } } while (0)
        SCAN_LOAD(0, 0); SCAN_LOAD(1, 1);
#pragma unroll
        for (int i = 0; i < 2; ++i) { const int piece = tid + 512 * i; const int row = piece >> 4, c8 = (piece & 15) * 8;
            *(LAS u32x4*)(QD + row * PQ + c8) = qv[0][i]; *(LAS u32x4*)(KI + krow * PQ + kc8 + 64 * i) = kv[0][i]; }
        __syncthreads();
        for (int step2 = 0; step2 < 36; step2 += 2) {
#pragma unroll
          for (int ss = 0; ss < 2; ++ss) {
            const int step = step2 + ss;
            const int tok0 = SCAN_TOK0(step);
#pragma unroll
            for (int i = 0; i < 2; ++i) { const int piece = tid + 512 * i;
                const f32x4 e0 = *(const LAS f32x4*)(ETL + step * 128 + kc8 + 64 * i), e1 = *(const LAS f32x4*)(ETL + step * 128 + kc8 + 64 * i + 4);
#pragma unroll
                for (int q = 0; q < 4; ++q) { const float klo = bf2f((unsigned short)(kv[ss][i][q] & 0xffff)), khi = bf2f((unsigned short)(kv[ss][i][q] >> 16));
                    const float elo = (2 * q < 4) ? e0[(2 * q) & 3] : e1[(2 * q) & 3], ehi = (2 * q + 1 < 4) ? e0[(2 * q + 1) & 3] : e1[(2 * q + 1) & 3];
                    KDT[(kc8 + 64 * i + 2 * q) * PS + krow] = f2bf(klo * elo); KDT[(kc8 + 64 * i + 2 * q + 1) * PS + krow] = f2bf(khi * ehi); }
                const int er = piece >> 3, pc = piece & 7; *(LAS u32x4*)(VTs + er * PS + 8 * pc) = vtv[ss][i]; }
            if (step + 2 < 36) SCAN_LOAD(step + 2, ss);
#define FRAG(base, row, pitch, ks) (*(const LAS bf16x8*)((base) + (row) * (pitch) + (ks) * 32 + fq * 8))
            {
                const int id0 = 2 * w, ct0 = id0 >> 2, st0 = id0 & 3, st1 = st0 + 1;
                bf16x8 qa[4], kb0[4], kb1[4];
#pragma unroll
                for (int ks = 0; ks < 4; ++ks) { qa[ks] = FRAG(QD, ct0 * 16 + fr, PQ, ks); kb0[ks] = FRAG(KI, st0 * 16 + fr, PQ, ks); kb1[ks] = FRAG(KI, st1 * 16 + fr, PQ, ks); }
#pragma unroll
                for (int dt = 0; dt < 8; ++dt) { const f32x4 dcv = *(const LAS f32x4*)(ETL + step * 128 + 16 * dt + 4 * fq); S[dt] = S[dt] * dcv; }
                __builtin_amdgcn_sched_barrier(0);
                f32x4 a0 = (f32x4){0.f, 0.f, 0.f, 0.f}, a1 = a0;
#pragma unroll
                for (int ks = 0; ks < 4; ++ks) { a0 = __builtin_amdgcn_mfma_f32_16x16x32_bf16(qa[ks], kb0[ks], a0, 0, 0, 0); a1 = __builtin_amdgcn_mfma_f32_16x16x32_bf16(qa[ks], kb1[ks], a1, 0, 0, 0); }
#pragma unroll
                for (int rg = 0; rg < 4; ++rg) { const int c_ = ct0 * 16 + 4 * fq + rg; const int s0_ = st0 * 16 + fr, s1_ = st1 * 16 + fr;
                    const bool k0_ = dir == 0 ? (s0_ <= c_) : (s0_ >= c_), k1_ = dir == 0 ? (s1_ <= c_) : (s1_ >= c_);
                    Pm[c_ * PS + s0_] = k0_ ? f2bf(a0[rg]) : (bf16_t)0; Pm[c_ * PS + s1_] = k1_ ? f2bf(a1[rg]) : (bf16_t)0; }
                bf16x8 sa[4];
#pragma unroll
                for (int ks = 0; ks < 4; ++ks) sa[ks] = FRAG(ST, 16 * w + fr, PQ, ks);
                f32x4 oacc[4];
#pragma unroll
                for (int ct = 0; ct < 4; ++ct) oacc[ct] = (f32x4){0.f, 0.f, 0.f, 0.f};
#pragma unroll
                for (int ct = 0; ct < 4; ++ct) {
                    bf16x8 qb[4];
#pragma unroll
                    for (int ks = 0; ks < 4; ++ks) qb[ks] = FRAG(QD, 16 * ct + fr, PQ, ks);
#pragma unroll
                    for (int ks = 0; ks < 4; ++ks) oacc[ct] = __builtin_amdgcn_mfma_f32_16x16x32_bf16(sa[ks], qb[ks], oacc[ct], 0, 0, 0);
                }
                __syncthreads();
                if (step + 1 < 36) {
#pragma unroll
                    for (int i = 0; i < 2; ++i) { const int piece = tid + 512 * i; const int row = piece >> 4, c8 = (piece & 15) * 8;
                        *(LAS u32x4*)(QD + row * PQ + c8) = qv[ss ^ 1][i]; *(LAS u32x4*)(KI + krow * PQ + kc8 + 64 * i) = kv[ss ^ 1][i]; }
                }
                bf16x8 va[2], pb[4][2];
#pragma unroll
                for (int ks = 0; ks < 2; ++ks) { va[ks] = FRAG(VTs, 16 * w + fr, PS, ks);
#pragma unroll
                    for (int ct = 0; ct < 4; ++ct) pb[ct][ks] = FRAG(Pm, 16 * ct + fr, PS, ks); }
                __builtin_amdgcn_sched_barrier(0);
#pragma unroll
                for (int ks = 0; ks < 2; ++ks)
#pragma unroll
                    for (int ct = 0; ct < 4; ++ct) oacc[ct] = __builtin_amdgcn_mfma_f32_16x16x32_bf16(va[ks], pb[ct][ks], oacc[ct], 0, 0, 0);
#pragma unroll
                for (int ct = 0; ct < 4; ++ct) { u32x2 wv; wv.x = cvt_pk_bf16(oacc[ct][0], oacc[ct][1]); wv.y = cvt_pk_bf16(oacc[ct][2], oacc[ct][3]);
                    *(u32x2*)(Od + (size_t)(tok0 + 16 * ct + fr) * DM + h * 256 + es * 128 + 16 * w + 4 * fq) = wv; }
#pragma unroll
                for (int half = 0; half < 2; ++half) {
                    bf16x8 ka[4][2];
#pragma unroll
                    for (int dd = 0; dd < 4; ++dd)
#pragma unroll
                        for (int ks = 0; ks < 2; ++ks) ka[dd][ks] = FRAG(KDT, 16 * (4 * half + dd) + fr, PS, ks);
                    __builtin_amdgcn_sched_barrier(0);
#pragma unroll
                    for (int ks = 0; ks < 2; ++ks)
#pragma unroll
                        for (int dd = 0; dd < 4; ++dd) S[4 * half + dd] = __builtin_amdgcn_mfma_f32_16x16x32_bf16(ka[dd][ks], va[ks], S[4 * half + dd], 0, 0, 0);
                }
#pragma unroll
                for (int dt = 0; dt < 8; ++dt) { u32x2 wv; wv.x = cvt_pk_bf16(S[dt][0], S[dt][1]); wv.y = cvt_pk_bf16(S[dt][2], S[dt][3]); *(LAS u32x2*)(ST + (16 * w + fr) * PQ + 16 * dt + 4 * fq) = wv; }
            }
#undef FRAG
            __syncthreads();
          }
        }
    }
}

#undef SCAN_LOAD
#undef SCAN_TOK0
__global__ void __launch_bounds__(512, 2) fwd_megakernel(Params P) {
    extern __shared__ __attribute__((aligned(16))) unsigned char lds_raw[];
    LAS unsigned char* lds = (LAS unsigned char*)lds_raw;
    cg::grid_group grid = cg::this_grid();
#define GSYNC0() do { asm volatile("s_waitcnt vmcnt(0) lgkmcnt(0)" ::: "memory"); __syncthreads(); grid.sync(); asm volatile("s_waitcnt vmcnt(0) lgkmcnt(0)" ::: "memory"); __syncthreads(); } while (0)
    volatile LAS unsigned* xb_st = (volatile LAS unsigned*)(lds + LDS_BYTES - 16);
    if (threadIdx.x == 0) { xb_st[0] = 0u; xb_st[1] = 0u; }
    __syncthreads();
    const XcdBarrier xbar = xcd_barrier_post((unsigned*)(P.ws + WS_CTL), xb_st);
    grid.sync();
#define GSYNC() xcd_barrier(xbar)
    const int G = gridDim.x, bx = blockIdx.x;
    unsigned char* ws = P.ws;
    float* mod = (float*)(ws + WS_MOD);
    float* Xl = P.out; float* Xc = (float*)(ws + WS_XCTX);
    bf16_t* HZ = (bf16_t*)(ws + WS_HZ); bf16_t* BIG = (bf16_t*)(ws + WS_BIG);
    bf16_t* QDf = (bf16_t*)(ws + WS_BIG); bf16_t* KIf = (bf16_t*)(ws + WS_BIG + 36 * MiB); bf16_t* QDb = (bf16_t*)(ws + WS_BIG + 72 * MiB); bf16_t* KIb = (bf16_t*)(ws + WS_BIG + 108 * MiB); bf16_t* VTb = (bf16_t*)(ws + WS_BIG + BIG_VT);
    float* ETb = (float*)(ws + WS_ET);
    bf16_t* Rb = (bf16_t*)(ws + WS_R); bf16_t* Obb = (bf16_t*)(ws + WS_OB);
    bf16_t* Dpb = (bf16_t*)(ws + WS_OB);
    bf16_t* Db = (bf16_t*)(ws + WS_R);

#ifndef NO_ADA
    ada_phase(lds, P);
#endif
    GSYNC();
#pragma unroll 1
    for (int layer = 0; layer < 4; ++layer) {
        const int kind = layer & 1, j = layer >> 1; const bool last = layer == 3;
        const float* modl = mod + (size_t)layer * NCOND * NADA;
        const float* src_lat = layer == 0 ? P.in[I_X] : Xl; const float* src_ctx = layer == 0 ? P.in[I_CTX] : Xc;
        const int Mall = TT, Mres = last ? TL : TT;
        unsigned char* wb = ws + ((layer & 1) ? WS_W2 : 0);
        bf16_t* Win_t = (bf16_t*)(wb + WS_WIN); bf16_t* Wout_t = (bf16_t*)(wb + WS_WOUT); bf16_t* Wf1_t = (bf16_t*)(wb + WS_WF1); bf16_t* Wf2_t = (bf16_t*)(wb + WS_WF2);
#ifndef NO_PREP
        prep_layer(lds, P, layer, 0, G);
#endif
        norm_mod_phase(src_lat, src_ctx, layer == 0 ? (const bf16_t*)nullptr : Db, Dpb, layer == 0 ? (float*)nullptr : Xl, Xc, P.in[I_N1G] + layer * DM, modl, 0, 1024, HZ, Mall);
        GSYNC();
        if (kind == 1) {
            pg8::Gemm g{HZ, Win_t, Mall, 3072, 1024}; pg8::StaticOrder S; S.init(Mall, 3072, 1024, G, bx);
            EpiGla E{QDf, KIf, QDb, KIb, Rb, ETb, P.in[I_GBR] + j * 1024, P.in[I_GBA] + j * 1024};
#ifndef NO_GGLA
            pg8::gemm_phase<EpiGla>(lds, g, S, E);
#endif
        }
        if (kind == 0) {
            pg8::Gemm g{HZ, Win_t, Mall, 3072, 1024}; pg8::StaticOrder S; S.init(Mall, 3072, 1024, G, bx);
            EpiConvIn E{BIG};
#ifndef NO_GPLAIN
            pg8::gemm_phase<EpiConvIn>(lds, g, S, E);
#endif
        } else {
            pg8::Gemm g{Win_t + (size_t)3072 * 1024, HZ, 1024, Mall, 1024}; pg8::StaticOrder S; S.init(1024, Mall, 1024, G, (bx + 64) % G);
            EpiPlain E{VTb, (size_t)TT};
#ifndef NO_GPLAIN
            pg8::gemm_phase<EpiPlain>(lds, g, S, E);
#endif
        }
        GSYNC();
        const bf16_t* Aout;
        if (kind == 0) {
            conv_phase(BIG, P.in[I_CW] + j * 3 * 1024, HZ, Mres);
            Aout = HZ;
        } else {
#ifndef NO_SCAN
            gla_scan_phase(lds, QDf, KIf, QDb, KIb, ETb, VTb, HZ, Obb);
#endif
            GSYNC();
            gla_out_phase(HZ, Obb, Rb, P.in[I_GNG] + j * 256, BIG, Mres);
            Aout = BIG;
        }
        GSYNC();
        {
            pg8::Gemm g{Aout, Wout_t, Mres, 1024, 1024};
            EpiDelta E{Db, modl + 2048, Dpb, last ? 0 : 1};
#ifndef NO_GRES
            if (last) { pg8::StaticOrder S; S.init(Mres, 1024, 1024, G, bx); pg8::gemm_phase<EpiDelta>(lds, g, S, E); }
            else { pg8::TailOrder S; S.init(1024, 1024, G, bx); pg8::gemm_phase<EpiDelta, pg8::TailOrder>(lds, g, S, E); }
#endif
        }
        GSYNC();
        norm_mod_phase(src_lat, src_ctx, Db, last ? (const bf16_t*)nullptr : Dpb, Xl, Xc, P.in[I_N2G] + layer * DM, modl, 3072, 4096, HZ, Mres);
        GSYNC();
        {
            pg8::Gemm g{HZ, Wf1_t, Mres, 5632, 1024}; pg8::StaticOrder S; S.init(Mres, 5632, 1024, G, bx);
            EpiSwiglu E{BIG};
#ifndef NO_GSWI
            pg8::gemm_phase<EpiSwiglu>(lds, g, S, E);
#endif
        }
        GSYNC();
        {
            pg8::Gemm g{BIG, Wf2_t, Mres, 1024, 2816};
            EpiDelta E{Db, modl + 5120, Dpb, last ? 0 : 1};
#ifndef NO_GRES
            if (last) { pg8::StaticOrder S; S.init(Mres, 1024, 2816, G, bx); pg8::gemm_phase<EpiDelta>(lds, g, S, E); }
            else { pg8::TailOrder S; S.init(1024, 2816, G, bx); pg8::gemm_phase<EpiDelta, pg8::TailOrder>(lds, g, S, E); }
#endif
        }
        GSYNC();
    }
    final_norm_phase(Xl, Db, P.in[I_FG], P.out);
}

extern "C" void kernel_launch(void* const* d_in, const int* in_sizes, int n_in, void* d_out, int out_size, void* d_ws, size_t ws_size, hipStream_t stream) {
    static int grid_blocks = 0;
    if (grid_blocks == 0) {
        if (n_in != 21 || ws_size < WS_END) { fprintf(stderr, "kernel_launch: unexpected n_in %d / ws_size %zu (need %zu)\n", n_in, ws_size, (size_t)WS_END); grid_blocks = -1; return; }
        int dev = 0, cus = 0, per_cu = 0;
        hipGetDevice(&dev);
        hipDeviceGetAttribute(&cus, hipDeviceAttributeMultiprocessorCount, dev);
        if (hipFuncSetAttribute((const void*)fwd_megakernel, hipFuncAttributeMaxDynamicSharedMemorySize, LDS_BYTES) != hipSuccess) { fprintf(stderr, "kernel_launch: hipFuncSetAttribute failed\n"); grid_blocks = -1; return; }
        if (hipOccupancyMaxActiveBlocksPerMultiprocessor(&per_cu, (const void*)fwd_megakernel, 512, LDS_BYTES) != hipSuccess || per_cu < 1) { fprintf(stderr, "kernel_launch: occupancy query says %d\n", per_cu); per_cu = 1; }
        (void)hipGetLastError();
        grid_blocks = cus;
    }
    if (grid_blocks < 0) return;
    if (hipMemsetAsync((char*)d_ws + WS_CTL, 0, XCD_BAR_WORDS * 4, stream) != hipSuccess) { fprintf(stderr, "kernel_launch: memset of the barrier words failed\n"); return; }
    Params p{};
    for (int i = 0; i < 21; ++i) p.in[i] = (const float*)d_in[i];
    p.out = (float*)d_out; p.ws = (unsigned char*)d_ws;
    void* args[] = {&p};
    hipError_t e = hipLaunchCooperativeKernel((const void*)fwd_megakernel, dim3(grid_blocks), dim3(512), args, LDS_BYTES, stream);
    if (e != hipSuccess) fprintf(stderr, "cooperative launch failed: %s (grid %d)\n", hipGetErrorString(e), grid_blocks);
}
```
